# Optimizing an MI355X kernel written in HIP

```python
import jax, jax.numpy as jnp
from jax import lax
import numpy as np

D_MODEL = 1024
BATCH = 8
SEQ = 4096
DEPTH = 4

N_HEADS = 8
HEAD_DIM = 64
N_KV = 2
GROUP = N_HEADS // N_KV
ATTN_WIDTH = N_HEADS * HEAD_DIM
KV_WIDTH = N_KV * HEAD_DIM
N_BRANCH = 3
CMP_BLOCK = 32
CMP_STRIDE = 16
CMP_HIDDEN = 256
SEL_BLOCK = 64
N_SEL = 16
WINDOW = 512
Q_BLOCK = 64
FORCE_BONUS = 1e3
CONV_CH = D_MODEL - ATTN_WIDTH
CONV_WIDTH = 31
D_FF = 2816
EPS = 1e-6
SPLITS = [ATTN_WIDTH] + [KV_WIDTH] * 6 + [N_HEADS * N_BRANCH, CONV_CH, CONV_CH]
IN_WIDTH = sum(SPLITS)

kernel_name = "hymba_nsa_conformer_macaron"


def rms_norm(x, g):
    x32 = x.astype(jnp.float32)
    y = x32 * lax.rsqrt(jnp.mean(x32 * x32, axis=-1, keepdims=True) + EPS)
    return (y * g.astype(jnp.float32)).astype(x.dtype)


def layer_norm(x, g, b):
    x32 = x.astype(jnp.float32)
    mu = jnp.mean(x32, axis=-1, keepdims=True)
    var = jnp.mean(jnp.square(x32 - mu), axis=-1, keepdims=True)
    y = (x32 - mu) * lax.rsqrt(var + EPS)
    return (y * g.astype(jnp.float32) + b.astype(jnp.float32)).astype(x.dtype)


def swiglu(h, w_gate, w_up, w_down):
    return (jax.nn.silu(h @ w_gate) * (h @ w_up)) @ w_down


def alibi_slopes():
    return jnp.exp2(-8.0 * jnp.arange(1, N_HEADS + 1, dtype=jnp.float32) / N_HEADS)


def masked_softmax(s, mask):
    p = jax.nn.softmax(jnp.where(mask, s, -1e30), axis=-1)
    return p * mask.astype(p.dtype)


def compress(k, pos, w1, w2):
    B, S = k.shape[0], k.shape[1]
    chunks = k.reshape(B, S // CMP_STRIDE, CMP_STRIDE, N_KV, HEAD_DIM)
    blocks = jnp.concatenate([chunks[:, :-1], chunks[:, 1:]], axis=2)
    blocks = blocks + pos[None, None, :, None, :]
    nc = blocks.shape[1]
    flat = blocks.transpose(0, 1, 3, 2, 4).reshape(B, nc, N_KV, CMP_BLOCK * HEAD_DIM)
    return jax.nn.silu(flat @ w1) @ w2


def nsa_attention(q, k_cmp, v_cmp, k_slc, v_slc, k_win, v_win, gates,
                  pos_k, wk1, wk2, pos_v, wv1, wv2):
    B, S = q.shape[0], q.shape[1]
    scale = HEAD_DIM ** -0.5
    kc = compress(k_cmp, pos_k, wk1, wk2)
    vc = compress(v_cmp, pos_v, wv1, wv2)
    nc = kc.shape[1]
    ns = S // SEL_BLOCK
    n_sel = min(N_SEL, ns)
    cmp_start = jnp.arange(nc) * CMP_STRIDE
    cmp_end = cmp_start + CMP_BLOCK - 1
    sel_start = jnp.arange(ns) * SEL_BLOCK
    overlap = jnp.clip(jnp.minimum(cmp_start[:, None] + CMP_BLOCK, sel_start[None] + SEL_BLOCK)
                       - jnp.maximum(cmp_start[:, None], sel_start[None]), 0).astype(jnp.float32) / CMP_BLOCK
    ks_blocks = k_slc.reshape(B, ns, SEL_BLOCK, N_KV, HEAD_DIM).transpose(0, 3, 1, 2, 4)
    vs_blocks = v_slc.reshape(B, ns, SEL_BLOCK, N_KV, HEAD_DIM).transpose(0, 3, 1, 2, 4)
    pad = jnp.zeros((B, WINDOW, N_KV, HEAD_DIM), k_win.dtype)
    kw_pad = jnp.concatenate([pad, k_win], axis=1)
    vw_pad = jnp.concatenate([pad, v_win], axis=1)
    qg = q.reshape(B, S, N_KV, GROUP, HEAD_DIM)
    gg = jax.nn.sigmoid(gates.reshape(B, S, N_KV, GROUP, N_BRANCH))
    slopes = alibi_slopes().reshape(N_KV, GROUP)[None, :, :, None, None]
    bidx = jnp.arange(B)[:, None, None, None]
    gidx = jnp.arange(N_KV)[None, :, None, None]
    sel_offs = jnp.arange(SEL_BLOCK)
    win_offs = jnp.arange(Q_BLOCK + WINDOW) - WINDOW
    blk = jnp.arange(ns)

    def chunk(c):
        q0 = c * Q_BLOCK
        qc = lax.dynamic_slice_in_dim(qg, q0, Q_BLOCK, axis=1)
        gc = lax.dynamic_slice_in_dim(gg, q0, Q_BLOCK, axis=1)
        t = q0 + jnp.arange(Q_BLOCK)
        m_c = cmp_end[None, :] <= t[:, None]
        d_c = (t[:, None] - cmp_end[None, :]).astype(jnp.float32)
        s_c = jnp.einsum('bqgrd,bngd->bgrqn', qc, kc, preferred_element_type=jnp.float32) * scale - slopes * d_c
        p_c = masked_softmax(s_c, m_c)
        o_cmp = jnp.einsum('bgrqn,bngd->bqgrd', p_c.astype(vc.dtype), vc)
        imp = jnp.einsum('bgrqn,nj->bgqj', p_c, overlap)
        tb = t // SEL_BLOCK
        forced = (blk[None] == 0) | (blk[None] == tb[:, None]) | (blk[None] == tb[:, None] - 1)
        valid = blk[None] * SEL_BLOCK <= t[:, None]
        score = jnp.where(valid, imp + jnp.where(forced, FORCE_BONUS, 0.0), -jnp.inf)
        _, idx = lax.top_k(score, n_sel)
        kg = ks_blocks[bidx, gidx, idx].reshape(B, N_KV, Q_BLOCK, n_sel * SEL_BLOCK, HEAD_DIM)
        vg = vs_blocks[bidx, gidx, idx].reshape(B, N_KV, Q_BLOCK, n_sel * SEL_BLOCK, HEAD_DIM)
        pos = (idx[..., None] * SEL_BLOCK + sel_offs).reshape(B, N_KV, Q_BLOCK, n_sel * SEL_BLOCK)
        d_s = (t[None, None, :, None] - pos)[:, :, None]
        s_s = jnp.einsum('bqgrd,bgqkd->bgrqk', qc, kg, preferred_element_type=jnp.float32) \
            - slopes * d_s.astype(jnp.float32)
        s_s = s_s * 1.0 if False else s_s
        s_s = jnp.einsum('bqgrd,bgqkd->bgrqk', qc, kg, preferred_element_type=jnp.float32) * scale \
            - slopes * d_s.astype(jnp.float32)
        p_s = masked_softmax(s_s, d_s >= 0)
        o_slc = jnp.einsum('bgrqk,bgqkd->bqgrd', p_s.astype(vg.dtype), vg)
        kw = lax.dynamic_slice_in_dim(kw_pad, q0, Q_BLOCK + WINDOW, axis=1)
        vw = lax.dynamic_slice_in_dim(vw_pad, q0, Q_BLOCK + WINDOW, axis=1)
        kpos = q0 + win_offs
        d_w = t[:, None] - kpos[None]
        m_w = (d_w >= 0) & (d_w < WINDOW) & (kpos[None] >= 0)
        s_w = jnp.einsum('bqgrd,bkgd->bgrqk', qc, kw, preferred_element_type=jnp.float32) * scale \
            - slopes * d_w.astype(jnp.float32)
        p_w = masked_softmax(s_w, m_w)
        o_win = jnp.einsum('bgrqk,bkgd->bqgrd', p_w.astype(vw.dtype), vw)
        return gc[..., 0, None] * o_cmp + gc[..., 1, None] * o_slc + gc[..., 2, None] * o_win

    out = lax.map(chunk, jnp.arange(S // Q_BLOCK))
    return out.transpose(1, 0, 2, 3, 4, 5).reshape(B, S, ATTN_WIDTH)


def conv_module(a, b, w, bias, g, beta):
    u = a * jax.nn.sigmoid(b)
    y = lax.conv_general_dilated(u, w[:, None, :].astype(u.dtype), (1,), [(CONV_WIDTH - 1, 0)],
                                 dimension_numbers=('NWC', 'WIO', 'NWC'),
                                 feature_group_count=CONV_CH) + bias
    return jax.nn.silu(layer_norm(y, g, beta))


def setup_inputs(seed: int = 0) -> dict:
    key = jax.random.key(seed)
    ks = jax.random.split(key, 32)
    L, D, F = DEPTH, D_MODEL, D_FF

    def nrm(k, shape, scale):
        return jax.random.normal(k, shape, jnp.float32) * scale

    def gain(k, shape):
        return 1.0 + 0.02 * jax.random.normal(k, shape, jnp.float32)

    return {
        "x": nrm(ks[0], (BATCH, SEQ, D), 1.0),
        "ffn1_norm": gain(ks[1], (L, D)),
        "ffn1_w_gate": nrm(ks[2], (L, D, F), D ** -0.5),
        "ffn1_w_up": nrm(ks[3], (L, D, F), D ** -0.5),
        "ffn1_w_down": nrm(ks[4], (L, F, D), F ** -0.5),
        "mix_norm": gain(ks[5], (L, D)),
        "w_in": nrm(ks[6], (L, D, IN_WIDTH), D ** -0.5),
        "cmp_pos_k": nrm(ks[7], (L, CMP_BLOCK, HEAD_DIM), 0.02),
        "cmp_k_w1": nrm(ks[8], (L, CMP_BLOCK * HEAD_DIM, CMP_HIDDEN), (CMP_BLOCK * HEAD_DIM) ** -0.5),
        "cmp_k_w2": nrm(ks[9], (L, CMP_HIDDEN, HEAD_DIM), CMP_HIDDEN ** -0.5),
        "cmp_pos_v": nrm(ks[10], (L, CMP_BLOCK, HEAD_DIM), 0.02),
        "cmp_v_w1": nrm(ks[11], (L, CMP_BLOCK * HEAD_DIM, CMP_HIDDEN), (CMP_BLOCK * HEAD_DIM) ** -0.5),
        "cmp_v_w2": nrm(ks[12], (L, CMP_HIDDEN, HEAD_DIM), CMP_HIDDEN ** -0.5),
        "conv_w": nrm(ks[13], (L, CONV_WIDTH, CONV_CH), CONV_WIDTH ** -0.5),
        "conv_b": nrm(ks[14], (L, CONV_CH), 0.02),
        "conv_norm_g": gain(ks[15], (L, CONV_CH)),
        "conv_norm_b": nrm(ks[16], (L, CONV_CH), 0.02),
        "w_out": nrm(ks[17], (L, D, D), D ** -0.5),
        "ffn2_norm": gain(ks[18], (L, D)),
        "ffn2_w_gate": nrm(ks[19], (L, D, F), D ** -0.5),
        "ffn2_w_up": nrm(ks[20], (L, D, F), D ** -0.5),
        "ffn2_w_down": nrm(ks[21], (L, F, D), F ** -0.5),
        "final_norm": gain(ks[22], (D,)),
    }


def reference(x, ffn1_norm, ffn1_w_gate, ffn1_w_up, ffn1_w_down, mix_norm, w_in,
              cmp_pos_k, cmp_k_w1, cmp_k_w2, cmp_pos_v, cmp_v_w1, cmp_v_w2,
              conv_w, conv_b, conv_norm_g, conv_norm_b, w_out,
              ffn2_norm, ffn2_w_gate, ffn2_w_up, ffn2_w_down, final_norm):
    B, S = x.shape[0], x.shape[1]
    offsets = [int(v) for v in np.cumsum(SPLITS)[:-1]]
    for l in range(DEPTH):
        x = x + 0.5 * swiglu(rms_norm(x, ffn1_norm[l]), ffn1_w_gate[l], ffn1_w_up[l], ffn1_w_down[l])
        z = rms_norm(x, mix_norm[l]) @ w_in[l]
        q, kc, vc, ks_, vs_, kw, vw, gl, ga, gb = jnp.split(z, offsets, axis=-1)
        kv = lambda t: t.reshape(B, S, N_KV, HEAD_DIM)
        attn = nsa_attention(q, kv(kc), kv(vc), kv(ks_), kv(vs_), kv(kw), kv(vw), gl,
                             cmp_pos_k[l], cmp_k_w1[l], cmp_k_w2[l],
                             cmp_pos_v[l], cmp_v_w1[l], cmp_v_w2[l])
        conv = conv_module(ga, gb, conv_w[l], conv_b[l], conv_norm_g[l], conv_norm_b[l])
        x = x + jnp.concatenate([attn, conv], axis=-1) @ w_out[l]
        x = x + 0.5 * swiglu(rms_norm(x, ffn2_norm[l]), ffn2_w_gate[l], ffn2_w_up[l], ffn2_w_down[l])
    return rms_norm(x, final_norm)
```

```cpp
#include <hip/hip_runtime.h>
#include <hip/hip_cooperative_groups.h>
#include <cstdio>
#include <cstdint>
namespace cg = cooperative_groups;
#ifndef EN_K
#define EN_K 0xfff
#endif
#ifndef DUP_K
#define DUP_K 0
#endif
#ifndef DUP_SYNC
#define DUP_SYNC 0
#endif
#ifndef EN_ATTN
#define EN_ATTN 1
#endif
#ifndef EN_CONV
#define EN_CONV 1
#endif
#ifndef EN_P0
#define EN_P0 1
#endif


#define LAS __attribute__((address_space(3)))
typedef unsigned short bf16_t;
typedef short bf16x8 __attribute__((ext_vector_type(8)));
typedef short s16x4 __attribute__((ext_vector_type(4)));
typedef float f32x4 __attribute__((ext_vector_type(4)));
typedef float f32x16 __attribute__((ext_vector_type(16)));
typedef unsigned u32x4 __attribute__((ext_vector_type(4)));
typedef unsigned u32x2 __attribute__((ext_vector_type(2)));
typedef float f32x2_t __attribute__((ext_vector_type(2)));
typedef __bf16 bf16x2_t __attribute__((ext_vector_type(2)));

__device__ __forceinline__ unsigned pk2(float lo, float hi) { f32x2_t v = {lo, hi}; bf16x2_t b = __builtin_convertvector(v, bf16x2_t); return __builtin_bit_cast(unsigned, b); }
__device__ __forceinline__ float bf2f(unsigned short u) { return __builtin_bit_cast(float, ((unsigned)u) << 16); }
__device__ __forceinline__ float bflo(unsigned u) { return __builtin_bit_cast(float, u << 16); }
__device__ __forceinline__ float bfhi(unsigned u) { return __builtin_bit_cast(float, u & 0xffff0000u); }
__device__ __forceinline__ float fsigmoid(float x) { return __builtin_amdgcn_rcpf(1.0f + __expf(-x)); }
__device__ __forceinline__ float fsilu(float x) { return x * fsigmoid(x); }
__device__ __forceinline__ float shflx(float v, int mask, int lane) { return __builtin_bit_cast(float, __builtin_amdgcn_ds_bpermute(((lane ^ mask) & 63) << 2, __builtin_bit_cast(int, v))); }
__device__ __forceinline__ unsigned shflxu(unsigned v, int mask, int lane) { return (unsigned)__builtin_amdgcn_ds_bpermute(((lane ^ mask) & 63) << 2, (int)v); }
__device__ __forceinline__ float wave_sum(float v, int lane) {
#pragma unroll
    for (int o = 1; o < 64; o <<= 1) v += shflx(v, o, lane);
    return v;
}

constexpr int NB = 8, SEQ = 4096, T = NB * SEQ, D = 1024, FF = 2816, NL = 4, INW = 2328;
constexpr float EPS = 1e-6f;
constexpr float LOG2E = 1.4426950408889634f;

constexpr size_t MiB = 1u << 20;
constexpr size_t WS_W = 0;
constexpr size_t W_LAYER = 20971520;
constexpr size_t OFF_SW1 = 0, OFF_DN1 = 5767168, OFF_WIN = 8650752, OFF_WOUT = 11272192, OFF_SW2 = 12320768, OFF_DN2 = 18087936;
constexpr size_t WS_CW1 = 160 * MiB;
constexpr size_t WS_CW2 = 168 * MiB;
constexpr size_t WS_BIAS1 = 169 * MiB;
constexpr size_t WS_H = 170 * MiB;
constexpr size_t WS_U = 234 * MiB;
constexpr size_t WS_Q = 234 * MiB;
constexpr size_t WS_KS = 266 * MiB, WS_VS = 274 * MiB, WS_KW = 282 * MiB, WS_VW = 290 * MiB;
constexpr size_t WS_KCMP = 298 * MiB;
constexpr size_t WS_GLU = 314 * MiB;
constexpr size_t WS_ATT = 346 * MiB;
constexpr size_t WS_G = 410 * MiB;
constexpr size_t WS_HID = 414 * MiB;
constexpr size_t WS_KC = 418 * MiB;
constexpr size_t WS_VC = WS_KC + 512 * 1024;
constexpr size_t WS_CTL = 420 * MiB;
constexpr size_t CTL_BYTES = 16384;
constexpr size_t WS_SSP = 421 * MiB;
constexpr size_t WS_BPART = 423 * MiB;
constexpr size_t WS_END = 424 * MiB;

constexpr int LDS_BYTES = 163840;
constexpr int LDS_MISC = LDS_BYTES - 64;

namespace pg8 {
constexpr int BM = 256, BK = 64, HALF = 128, HTB = HALF * BK * 2, STAGE_BYTES = 8 * HTB, NXCD = 8, WGM = 8;
__host__ __device__ __forceinline__ int lds_byte(int r, int c) { const int st = (r >> 4) * 2 + (c >> 5), rr = r & 15, cc = c & 31, ob = rr * 64 + cc * 2; return st * 1024 + (ob ^ (((ob >> 9) & 1) << 5)); }
__host__ __device__ __forceinline__ void stage_rc(int b, int& R, int& C) { const int st = b / 1024, sb = b % 1024, swz = sb ^ (((sb >> 9) & 1) << 5); R = (st >> 1) * 16 + swz / 64; C = (st & 1) * 32 + (swz % 64) / 2; }
__host__ __device__ __forceinline__ int perm32(int rho) { const int n = rho >> 4, i = rho & 15; return 8 * (i >> 2) + 4 * n + (i & 3); }
struct Unit { int pm, pn; };
struct Gemm { const bf16_t* A; const bf16_t* Bt; int M, N, K, lda; };
struct StaticOrder {
    int nM, nN, nwg, G, c;
    __host__ __device__ void init(int M, int N, int G_, int c_) { nM = M / BM; nN = N / BM; nwg = nM * nN; G = G_; c = c_; }
    __host__ __device__ bool next(int i, Unit& u) const {
        const long L = (long)i * G + c; if (L >= nwg) return false;
        int wgid = (int)L; { const int q = nwg / NXCD, r = nwg % NXCD, xcd = wgid % NXCD, off = wgid / NXCD; wgid = (xcd < r ? xcd * (q + 1) : r * (q + 1) + (xcd - r) * q) + off; }
        const int nig = WGM * nN, gid = wgid / nig, fm = gid * WGM, gsz = (nM - fm) < WGM ? (nM - fm) : WGM;
        u.pm = fm + ((wgid % nig) % gsz); u.pn = (wgid % nig) / gsz; return true;
    }
};
struct AuxOrder {
    int j;
    __host__ __device__ bool next(int i, Unit& u) const {
        int v;
        if (j < 0) return false;
        if (j < 32) { if (i >= 2) return false; v = 2 * j + i; u.pm = v >> 1; u.pn = v & 1; return true; }
        if (i >= 1 || j >= 224) return false;
        const int jj = j - 32, grp = jj >> 4, within = jj & 15;
        u.pm = 32 + grp * 8 + (within & 7); u.pn = within >> 3; return true;
    }
};
struct CmpOrder {
    int G, c;
    __host__ __device__ bool next(int i, Unit& u) const { const int L = i * G + c; if (L >= 32) return false; u.pm = L; u.pn = L >> 4; return true; }
};

template <class Epi, class Sched>
__device__ __forceinline__ void gemm_phase(LAS unsigned char* lds, const Gemm g, const Sched S, const Epi E, const int tid) {
    const int wid = __builtin_amdgcn_readfirstlane(tid >> 6), lane = tid & 63, wr = wid >> 2, wc = wid & 3, fr = lane & 15, fq = lane >> 4;
    const int K = g.K, nt = K / BK, lda = g.lda;
    unsigned voffA[2], voffB[2];
#pragma unroll
    for (int i = 0; i < 2; ++i) { int R, C; stage_rc(tid * 16 + i * 8192, R, C); const int Rb = Epi::PERM ? ((R & ~31) + perm32(R & 31)) : R;
        voffA[i] = (unsigned)(R * lda + C) * 2u; voffB[i] = (unsigned)(Rb * K + C) * 2u; }
    const size_t kstep = (size_t)(BK * 2);
    const size_t hstepA = (size_t)HALF * lda * 2, hstepB = (size_t)HALF * K * 2;
    const size_t tstepA = 2 * hstepA, tstepB = 2 * hstepB;
    const unsigned ldsw = (unsigned)wid * 1024u;
    const int aoff = lds_byte(wr * 64 + fr, fq * 8), boff = lds_byte(wc * 32 + fr, fq * 8);
#define PG8_SA(b, h) (((b) * 2 + (h)) * HTB)
#define PG8_SB(b, h) ((4 + (b) * 2 + (h)) * HTB)
#define PG8_STAGE(bufoff, gbase, voff) do { _Pragma("unroll") for (int _i = 0; _i < 2; ++_i) \
        __builtin_amdgcn_global_load_lds((const unsigned*)((const char*)(gbase) + (voff)[_i]), (LAS unsigned*)(lds + (bufoff) + ldsw + _i * 8192), 16, 0, 0); } while (0)
#define PG8_LDA(dst, b, h) do { _Pragma("unroll") for (int m = 0; m < 4; ++m) _Pragma("unroll") for (int k = 0; k < 2; ++k) dst[m][k] = *(const LAS bf16x8*)(lds + PG8_SA(b, h) + aoff + m * 2048 + k * 1024); } while (0)
#define PG8_LDB(dst, b, h) do { _Pragma("unroll") for (int n = 0; n < 2; ++n) _Pragma("unroll") for (int k = 0; k < 2; ++k) dst[n][k] = *(const LAS bf16x8*)(lds + PG8_SB(b, h) + boff + n * 2048 + k * 1024); } while (0)
#define PG8_MMA(ai, bj, At, Bt) do { __builtin_amdgcn_s_setprio(1); _Pragma("unroll") for (int m = 0; m < 4; ++m) _Pragma("unroll") for (int n = 0; n < 2; ++n) _Pragma("unroll") for (int k = 0; k < 2; ++k) \
        acc[ai][bj][m][n] = __builtin_amdgcn_mfma_f32_16x16x32_bf16(Bt[n][k], At[m][k], acc[ai][bj][m][n], 0, 0, 0); __builtin_amdgcn_s_setprio(0); } while (0)
#define PG8_WAIT_V(n) asm volatile("s_waitcnt vmcnt(" #n ")" ::: "memory")
#define PG8_WAIT_L(n) asm volatile("s_waitcnt lgkmcnt(" #n ")" ::: "memory")
#define PG8_BAR __builtin_amdgcn_s_barrier()
#define PG8_SCHED __builtin_amdgcn_sched_barrier(0)
    Unit cur, nxt; int ui = 0;
    if (!S.next(0, cur)) return;
    f32x4 acc[2][2][4][2];
#pragma unroll
    for (int a = 0; a < 2; ++a)
#pragma unroll
        for (int b = 0; b < 2; ++b)
#pragma unroll
            for (int m = 0; m < 4; ++m)
#pragma unroll
                for (int n = 0; n < 2; ++n) acc[a][b][m][n] = (f32x4){0.f, 0.f, 0.f, 0.f};
    bf16x8 At[4][2], B0[2][2], B1[2][2];
    const char* cA = (const char*)g.A + (size_t)cur.pm * tstepA; const char* cB = (const char*)g.Bt + (size_t)cur.pn * tstepB;
    PG8_STAGE(PG8_SB(0, 0), cB, voffB); PG8_STAGE(PG8_SB(0, 1), cB + hstepB, voffB); PG8_STAGE(PG8_SA(0, 0), cA, voffA); PG8_STAGE(PG8_SA(0, 1), cA + hstepA, voffA);
    if (wr == 1) PG8_BAR;
    PG8_WAIT_V(2); PG8_BAR;
    PG8_STAGE(PG8_SB(1, 0), cB + kstep, voffB); PG8_STAGE(PG8_SA(1, 0), cA + kstep, voffA); PG8_STAGE(PG8_SB(1, 1), cB + hstepB + kstep, voffB);
    PG8_WAIT_V(6); PG8_BAR;
    for (;;) {
        const bool has_next = S.next(ui + 1, nxt);
        const char* nA = has_next ? (const char*)g.A + (size_t)nxt.pm * tstepA : cA; const char* nB = has_next ? (const char*)g.Bt + (size_t)nxt.pn * tstepB : cB;
        for (int t = 0; t < nt; t += 2) {
            const bool last = (t == nt - 2);
            const char* a1 = cA + (size_t)(t + 1) * kstep;
            const char* a2 = last ? nA : cA + (size_t)(t + 2) * kstep; const char* b2 = last ? nB : cB + (size_t)(t + 2) * kstep;
            const char* a3 = a2 + kstep; const char* b3 = b2 + kstep;
            PG8_LDB(B0, 0, 0); PG8_LDB(B1, 0, 1); PG8_SCHED; PG8_LDA(At, 0, 0); PG8_STAGE(PG8_SA(1, 1), a1 + hstepA, voffA);
            PG8_WAIT_V(8); PG8_WAIT_L(0); PG8_BAR; PG8_MMA(0, 0, At, B0); PG8_MMA(0, 1, At, B1); PG8_BAR; PG8_SCHED;
            PG8_LDA(At, 0, 1); PG8_STAGE(PG8_SB(0, 0), b2, voffB); PG8_STAGE(PG8_SB(0, 1), b2 + hstepB, voffB); PG8_STAGE(PG8_SA(0, 0), a2, voffA);
            PG8_WAIT_V(8); PG8_WAIT_L(0); PG8_BAR; PG8_MMA(1, 0, At, B0); PG8_MMA(1, 1, At, B1); PG8_BAR; PG8_SCHED;
            PG8_LDB(B0, 1, 0); PG8_LDB(B1, 1, 1); PG8_SCHED; PG8_LDA(At, 1, 0); PG8_STAGE(PG8_SA(0, 1), a2 + hstepA, voffA);
            PG8_WAIT_V(8); PG8_WAIT_L(0); PG8_BAR; PG8_MMA(0, 0, At, B0); PG8_MMA(0, 1, At, B1); PG8_BAR; PG8_SCHED;
            PG8_LDA(At, 1, 1); PG8_STAGE(PG8_SB(1, 0), b3, voffB); PG8_STAGE(PG8_SB(1, 1), b3 + hstepB, voffB); PG8_STAGE(PG8_SA(1, 0), a3, voffA);
            PG8_WAIT_V(8); PG8_WAIT_L(0); PG8_BAR; PG8_MMA(1, 0, At, B0); PG8_MMA(1, 1, At, B1); PG8_BAR; PG8_SCHED;
        }
        if (wr == 0) PG8_BAR;
        { int fr_ = fr, fq_ = fq; asm volatile("" : "+v"(fr_), "+v"(fq_));
          E(acc, cur, wr, wc, fr_, fq_); }
        if (!has_next) break;
#pragma unroll
        for (int a = 0; a < 2; ++a)
#pragma unroll
            for (int b = 0; b < 2; ++b)
#pragma unroll
                for (int m = 0; m < 4; ++m)
#pragma unroll
                    for (int n = 0; n < 2; ++n) acc[a][b][m][n] = (f32x4){0.f, 0.f, 0.f, 0.f};
        cur = nxt; cA = nA; cB = nB; ++ui;
        if (wr == 1) PG8_BAR;
    }
    PG8_WAIT_V(0);
    PG8_BAR;
#undef PG8_SA
#undef PG8_SB
#undef PG8_STAGE
#undef PG8_LDA
#undef PG8_LDB
#undef PG8_MMA
#undef PG8_WAIT_V
#undef PG8_WAIT_L
#undef PG8_BAR
#undef PG8_SCHED
}

__device__ __forceinline__ float row_rscale(const float* SSP, int row) {
    const f32x4 p = *(const f32x4*)(SSP + (size_t)row * 4);
    return rsqrtf(((p[0] + p[1]) + (p[2] + p[3])) * (1.f / 1024.f) + 1e-6f);
}
__device__ __forceinline__ void row_scales8(const float* SSP, int row0, int key, LAS float* rsc  , LAS int* rtag  , int wv, int fr, int fq, float (&rsv)[2][4]) {
    const int tag = __builtin_amdgcn_readfirstlane(rtag[wv]);
    LAS float* tab = rsc + (wv * 16 + fr) * 8;
    if (tag == key) {
        const f32x4 a = *(const LAS f32x4*)tab, b = *(const LAS f32x4*)(tab + 4);
#pragma unroll
        for (int m = 0; m < 4; ++m) { rsv[0][m] = a[m]; rsv[1][m] = b[m]; }
    } else {
#pragma unroll
        for (int ai = 0; ai < 2; ++ai)
#pragma unroll
            for (int m = 0; m < 4; ++m) rsv[ai][m] = row_rscale(SSP, row0 + ai * HALF + m * 16);
        if (fq == 0) { *(LAS f32x4*)tab = (f32x4){rsv[0][0], rsv[0][1], rsv[0][2], rsv[0][3]}; *(LAS f32x4*)(tab + 4) = (f32x4){rsv[1][0], rsv[1][1], rsv[1][2], rsv[1][3]}; if (fr == 0) rtag[wv] = key; }
    }
}
typedef float f32x2 __attribute__((ext_vector_type(2)));
__device__ __forceinline__ f32x2 swiglu_pk(f32x2 g, f32x2 u, float c1, float rs2) {
    const f32x2 t = g * c1; f32x2 e; e.x = __builtin_amdgcn_exp2f(t.x); e.y = __builtin_amdgcn_exp2f(t.y);
    const f32x2 d = e + 1.0f; f32x2 sg; sg.x = __builtin_amdgcn_rcpf(d.x); sg.y = __builtin_amdgcn_rcpf(d.y);
    return (g * u) * (sg * rs2);
}
__device__ __forceinline__ f32x2 glu_pk(f32x2 a, f32x2 b, float c1, float rs) {
    const f32x2 t = b * c1; f32x2 e; e.x = __builtin_amdgcn_exp2f(t.x); e.y = __builtin_amdgcn_exp2f(t.y);
    const f32x2 d = e + 1.0f; f32x2 sg; sg.x = __builtin_amdgcn_rcpf(d.x); sg.y = __builtin_amdgcn_rcpf(d.y);
    return a * (sg * rs);
}
struct EpiSwiglu {
    static constexpr bool PERM = true;
    bf16_t* U; const float* SSP; LAS float* rsc; LAS int* rtag; int key0;
    __device__ __forceinline__ void operator()(const f32x4 (&acc)[2][2][4][2], const Unit& u, int wr, int wc, int fr, int fq) const {
        const int row0 = u.pm * BM + wr * 64 + fr, col0 = u.pn * 128 + wc * 32 + 8 * fq;
        float rsv[2][4];
        row_scales8(SSP, row0, key0 + u.pm, rsc, rtag, wr * 4 + wc, fr, fq, rsv);
#pragma unroll
        for (int ai = 0; ai < 2; ++ai) {
#pragma unroll
            for (int m = 0; m < 4; ++m) {
                const int row = row0 + ai * HALF + m * 16;
                const float rs = rsv[ai][m];
                bf16_t* rowp = U + (size_t)row * FF + col0;
                const float c1 = -rs * LOG2E, rs2 = rs * rs;
                const f32x4 g0 = acc[ai][0][m][0], g1 = acc[ai][0][m][1], u0 = acc[ai][1][m][0], u1 = acc[ai][1][m][1];
                const f32x2 o0 = swiglu_pk((f32x2){g0[0], g0[1]}, (f32x2){u0[0], u0[1]}, c1, rs2), o1 = swiglu_pk((f32x2){g0[2], g0[3]}, (f32x2){u0[2], u0[3]}, c1, rs2);
                const f32x2 o2 = swiglu_pk((f32x2){g1[0], g1[1]}, (f32x2){u1[0], u1[1]}, c1, rs2), o3 = swiglu_pk((f32x2){g1[2], g1[3]}, (f32x2){u1[2], u1[3]}, c1, rs2);
                u32x4 w; w.x = pk2(o0.x, o0.y); w.y = pk2(o1.x, o1.y); w.z = pk2(o2.x, o2.y); w.w = pk2(o3.x, o3.y);
                *(u32x4*)rowp = w;
            }
        }
    }
};
struct EpiResid {
    static constexpr bool PERM = true;
    bf16_t* XB; float* SSP; float scale; LAS float* red;
    __device__ __forceinline__ void operator()(const f32x4 (&acc)[2][2][4][2], const Unit& u, int wr, int wc, int fr, int fq) const {
        const int row0 = u.pm * BM + wr * 64 + fr, col0 = u.pn * BM + wc * 32 + 8 * fq;
#pragma unroll
        for (int ai = 0; ai < 2; ++ai) {
            u32x4 xin[4][2];
#pragma unroll
            for (int m = 0; m < 4; ++m) { const size_t ro = (size_t)(row0 + ai * HALF + m * 16) * D + col0; xin[m][0] = *(const u32x4*)(XB + ro); xin[m][1] = *(const u32x4*)(XB + ro + HALF); }
#pragma unroll
            for (int m = 0; m < 4; ++m) {
                const int row = row0 + ai * HALF + m * 16;
                const size_t ro = (size_t)row * D + col0;
                float ss = 0.f;
#pragma unroll
                for (int bj = 0; bj < 2; ++bj) {
                    const u32x4 xi = xin[m][bj];
                    const f32x4 a0 = acc[ai][bj][m][0] * scale, a1 = acc[ai][bj][m][1] * scale;
                    u32x4 w;
                    w.x = pk2(bflo(xi.x) + a0[0], bfhi(xi.x) + a0[1]); w.y = pk2(bflo(xi.y) + a0[2], bfhi(xi.y) + a0[3]);
                    w.z = pk2(bflo(xi.z) + a1[0], bfhi(xi.z) + a1[1]); w.w = pk2(bflo(xi.w) + a1[2], bfhi(xi.w) + a1[3]);
                    *(u32x4*)(XB + ro + bj * HALF) = w;
                    const float r0 = bflo(w.x), r1 = bfhi(w.x), r2 = bflo(w.y), r3 = bfhi(w.y), r4 = bflo(w.z), r5 = bfhi(w.z), r6 = bflo(w.w), r7 = bfhi(w.w);
                    ss += ((r0 * r0 + r1 * r1) + (r2 * r2 + r3 * r3)) + ((r4 * r4 + r5 * r5) + (r6 * r6 + r7 * r7));
                }
                { const int ln_ = fq * 16 + fr; ss += shflx(ss, 16, ln_); ss += shflx(ss, 32, ln_); }
                if (fq == 0) red[((wr * 4 + wc) * 8 + ai * 4 + m) * 16 + fr] = ss;
            }
        }
        asm volatile("s_waitcnt lgkmcnt(0)" ::: "memory"); __builtin_amdgcn_s_barrier(); asm volatile("" ::: "memory");
        if (wc == 0) {
            const int ln_ = fq * 16 + fr;
#pragma unroll
            for (int e = 0; e < 2; ++e) {
                const int idx = ln_ + 64 * e, k = idx >> 4, f = idx & 15;
                const float sum = (red[((wr * 4 + 0) * 8 + k) * 16 + f] + red[((wr * 4 + 1) * 8 + k) * 16 + f]) + (red[((wr * 4 + 2) * 8 + k) * 16 + f] + red[((wr * 4 + 3) * 8 + k) * 16 + f]);
                SSP[(size_t)(u.pm * BM + (k >> 2) * HALF + wr * 64 + (k & 3) * 16 + f) * 4 + u.pn] = sum;
            }
        }
    }
};
template <int TILE0> struct EpiWinT {
    static constexpr bool PERM = true;
    unsigned char* ws; LAS float* rsc; LAS int* rtag; int key0;
    __device__ __forceinline__ void operator()(const f32x4 (&acc)[2][2][4][2], const Unit& u, int wr, int wc, int fr, int fq) const {
        const int row0 = u.pm * BM + wr * 64 + fr, cl = wc * 32 + 8 * fq;
        const int pn = TILE0 + u.pn;
        float rsv[2][4];
        row_scales8((const float*)(ws + WS_SSP), row0, key0 + u.pm, rsc, rtag, wr * 4 + wc, fr, fq, rsv);
#pragma unroll
        for (int ai = 0; ai < 2; ++ai) {
#pragma unroll
            for (int m = 0; m < 4; ++m) {
                const int row = row0 + ai * HALF + m * 16;
                const float rs = rsv[ai][m];
                if (pn >= 4 && pn <= 7) {
                    const float c1 = -rs * LOG2E;
                    const f32x4 a0 = acc[ai][0][m][0], a1 = acc[ai][0][m][1], b0 = acc[ai][1][m][0], b1 = acc[ai][1][m][1];
                    const f32x2 o0 = glu_pk((f32x2){a0[0], a0[1]}, (f32x2){b0[0], b0[1]}, c1, rs), o1 = glu_pk((f32x2){a0[2], a0[3]}, (f32x2){b0[2], b0[3]}, c1, rs);
                    const f32x2 o2 = glu_pk((f32x2){a1[0], a1[1]}, (f32x2){b1[0], b1[1]}, c1, rs), o3 = glu_pk((f32x2){a1[2], a1[3]}, (f32x2){b1[2], b1[3]}, c1, rs);
                    u32x4 w; w.x = pk2(o0.x, o0.y); w.y = pk2(o1.x, o1.y); w.z = pk2(o2.x, o2.y); w.w = pk2(o3.x, o3.y);
                    *(u32x4*)((bf16_t*)(ws + WS_GLU) + (size_t)row * 512 + (pn - 4) * 128 + cl) = w;
                } else if (pn == 9) {
                    if (wc == 0) {
                        const f32x4 a0 = acc[ai][0][m][0] * rs, a1 = acc[ai][0][m][1] * rs;
                        float* gp = (float*)(ws + WS_G) + (size_t)row * 32 + 8 * fq;
                        *(f32x4*)gp = (f32x4){fsigmoid(a0[0]), fsigmoid(a0[1]), fsigmoid(a0[2]), fsigmoid(a0[3])};
                        *(f32x4*)(gp + 4) = (f32x4){fsigmoid(a1[0]), fsigmoid(a1[1]), fsigmoid(a1[2]), fsigmoid(a1[3])};
                    }
                } else {
#pragma unroll
                    for (int bj = 0; bj < 2; ++bj) {
                        const float rq = (pn < 2) ? rs * (0.125f * LOG2E) : rs;
                        const f32x4 v0 = acc[ai][bj][m][0] * rq, v1 = acc[ai][bj][m][1] * rq;
                        u32x4 w; w.x = pk2(v0[0], v0[1]); w.y = pk2(v0[2], v0[3]); w.z = pk2(v1[0], v1[1]); w.w = pk2(v1[2], v1[3]);
                        bf16_t* dst;
                        if (pn < 2) dst = (bf16_t*)(ws + WS_Q) + (size_t)row * 512 + pn * 256 + bj * 128 + cl;
                        else if (pn == 2) { const int b = row >> 12, tok = row & 4095, gg = cl >> 6, d0 = cl & 63;
                            dst = (bf16_t*)(ws + WS_KCMP) + ((size_t)((bj * 16 + b * 2 + gg) * 4096 + tok)) * 64 + d0; }
                        else if (pn == 3) dst = (bf16_t*)(ws + (bj ? WS_VS : WS_KS)) + (size_t)row * 128 + cl;
                        else dst = (bf16_t*)(ws + (bj ? WS_VW : WS_KW)) + (size_t)row * 128 + cl;
                        *(u32x4*)dst = w;
                    }
                }
            }
        }
    }
};
struct EpiCmp1 {
    static constexpr bool PERM = true;
    bf16_t* HID; const float* bias1;
    __device__ __forceinline__ void operator()(const f32x4 (&acc)[2][2][4][2], const Unit& u, int wr, int wc, int fr, int fq) const {
        const int row0 = u.pm * BM + wr * 64 + fr, cl = wc * 32 + 8 * fq;
        const float* bb = bias1 + u.pn * 256;
#pragma unroll
        for (int bj = 0; bj < 2; ++bj) {
            const f32x4 c0 = *(const f32x4*)(bb + bj * 128 + cl), c1 = *(const f32x4*)(bb + bj * 128 + cl + 4);
#pragma unroll
            for (int ai = 0; ai < 2; ++ai)
#pragma unroll
                for (int m = 0; m < 4; ++m) {
                    const f32x4 v0 = acc[ai][bj][m][0] + c0, v1 = acc[ai][bj][m][1] + c1;
                    u32x4 w; w.x = pk2(fsilu(v0[0]), fsilu(v0[1])); w.y = pk2(fsilu(v0[2]), fsilu(v0[3])); w.z = pk2(fsilu(v1[0]), fsilu(v1[1])); w.w = pk2(fsilu(v1[2]), fsilu(v1[3]));
                    *(u32x4*)(HID + (size_t)(row0 + ai * HALF + m * 16) * 256 + bj * 128 + cl) = w;
                }
        }
    }
};
struct EpiCmp2 {
    static constexpr bool PERM = false;
    bf16_t* KC; bf16_t* VC;
    __device__ __forceinline__ void operator()(const f32x4 (&acc)[2][2][4][2], const Unit& u, int wr, int wc, int fr, int fq) const {
        if (wc >= 2) return;
        bf16_t* dst = u.pn ? VC : KC;
        const int slab = u.pm & 15, b = slab >> 1, gg = slab & 1;
#pragma unroll
        for (int ai = 0; ai < 2; ++ai)
#pragma unroll
            for (int m = 0; m < 4; ++m) {
                const int nrow = ai * HALF + wr * 64 + m * 16 + fr;
#pragma unroll
                for (int n = 0; n < 2; ++n) {
                    f32x4 v = acc[ai][0][m][n]; if (nrow == 255) v = (f32x4){0.f, 0.f, 0.f, 0.f};
                    u32x2 w; w.x = pk2(v[0], v[1]); w.y = pk2(v[2], v[3]);
                    *(u32x2*)(dst + (size_t)(b * 256 + nrow) * 128 + gg * 64 + wc * 32 + 16 * n + 4 * fq) = w;
                }
            }
    }
};
}

struct Args { const float* in[23]; float* out; unsigned char* ws; int ph_lo, ph_hi; };

__device__ __forceinline__ void transpose_tile(const float* colp  , int ld, int K, bf16_t* dst, int n0, int k0, const float* gk, LAS unsigned char* lds, int tid) {
    const int c4 = tid & 31, kql = tid >> 5;
    f32x4 rr[4][4];
#pragma unroll
    for (int step = 0; step < 4; ++step) {
        const int kk = k0 + 4 * (step * 16 + kql);
#pragma unroll
        for (int i = 0; i < 4; ++i) rr[step][i] = colp ? __builtin_nontemporal_load((const f32x4*)(colp + (size_t)(kk + i) * ld)) : (f32x4){0.f, 0.f, 0.f, 0.f};
    }
#pragma unroll
    for (int step = 0; step < 4; ++step) {
        const int kq = step * 16 + kql, kk = k0 + 4 * kq;
        f32x4 r0 = rr[step][0], r1 = rr[step][1], r2 = rr[step][2], r3 = rr[step][3];
        if (gk) { const f32x4 gg = *(const f32x4*)(gk + kk); r0 *= gg[0]; r1 *= gg[1]; r2 *= gg[2]; r3 *= gg[3]; }
        const int phys = kq ^ (c4 & 15);
#pragma unroll
        for (int e = 0; e < 4; ++e) { u32x2 w; w.x = pk2(r0[e], r1[e]); w.y = pk2(r2[e], r3[e]); *(LAS u32x2*)(lds + (4 * c4 + e) * 512 + phys * 8) = w; }
    }
    __syncthreads();
#pragma unroll
    for (int it = 0; it < 8; ++it) {
        const int id = it * 512 + tid, row = id >> 5, q = id & 31, sw = (row >> 2) & 15;
        u32x4 v = *(const LAS u32x4*)(lds + row * 512 + (q ^ (sw >> 1)) * 16);
        if (sw & 1) v = (u32x4){v.z, v.w, v.x, v.y};
        *(u32x4*)(dst + (size_t)(n0 + row) * K + k0 + 8 * q) = v;
    }
    __syncthreads();
}

__device__ __forceinline__ void p0_phase(const Args& a, unsigned char* ws, LAS unsigned char* lds, const int tid, const int bid) {
    const int lane = tid & 63, wave = tid >> 6;
    const int gw = bid * 8 + wave, NGW = gridDim.x * 8;
    constexpr int JA = 176, JB = 88, JC = 80, JD = 32, JG = 32, JH = 4, JPL = 2 * (JA + JB) + JC + JD + JG + JH;
    for (int it = bid; it < NL * JPL; it += gridDim.x) {
        const int l = it / JPL; int r = it % JPL;
        bf16_t* wl = (bf16_t*)(ws + WS_W) + (size_t)l * W_LAYER;
        const int c4 = tid & 31;
        const float* colp = nullptr; int ld = 0, K = 0, n0 = 0, k0 = 0; bf16_t* dst = nullptr; const float* gk = nullptr;
        if (r < JA || (r >= JA + JB + JC + JD && r < JA + JB + JC + JD + JA)) {
            const bool second = r >= JA; if (second) r -= JA + JB + JC + JD;
            const int kb = r / 44, nb = r % 44; K = 1024; k0 = kb * 256; n0 = nb * 128; ld = FF;
            const int np = n0 + 4 * c4, tile = np >> 8, within = np & 255;
            const float* src = (within < 128) ? a.in[second ? 19 : 2] : a.in[second ? 20 : 3];
            colp = src + (size_t)l * D * FF + tile * 128 + (within & 127);
            dst = wl + (second ? OFF_SW2 : OFF_SW1); gk = a.in[second ? 18 : 1] + l * D;
        } else if ((r >= JA && r < JA + JB) || (r >= JA + JB + JC + JD + JA && r < JA + JB + JC + JD + JA + JB)) {
            const bool second = r >= JA + JB; r -= second ? (JA + JB + JC + JD + JA) : JA;
            const int kb = r / 8, nb = r % 8; K = FF; k0 = kb * 256; n0 = nb * 128; ld = D;
            colp = a.in[second ? 21 : 4] + (size_t)l * FF * D + n0 + 4 * c4;
            dst = wl + (second ? OFF_DN2 : OFF_DN1);
        } else if (r < JA + JB + JC) {
            r -= JA + JB;
            const int kb = r / 20, nb = r % 20; K = 1024; k0 = kb * 256; n0 = nb * 128; ld = INW;
            const int np = n0 + 4 * c4; int col;
            if (np < 1024) col = np;
            else if (np < 2048) { const int tt = (np - 1024) >> 8, within = (np - 1024) & 255; col = (within < 128) ? (1304 + 128 * tt + within) : (1816 + 128 * tt + within - 128); }
            else if (np < 2304) col = 1024 + (np - 2048);
            else { const int within = np - 2304; col = within < 24 ? 1280 + within : -1; }
            colp = col >= 0 ? a.in[6] + (size_t)l * D * INW + col : nullptr;
            dst = wl + OFF_WIN; gk = a.in[5] + l * D;
        } else if (r < JA + JB + JC + JD) {
            r -= JA + JB + JC;
            const int kb = r / 8, nb = r % 8; K = 1024; k0 = kb * 256; n0 = nb * 128; ld = D;
            colp = a.in[17] + (size_t)l * D * D + n0 + 4 * c4;
            dst = wl + OFF_WOUT;
        } else if (r < 2 * (JA + JB) + JC + JD + JG) {
            r -= 2 * (JA + JB) + JC + JD;
            const int kb = r / 4, nb = r % 4; K = 2048; k0 = kb * 256; n0 = nb * 128; ld = 256;
            const int np = n0 + 4 * c4, kv = np >> 8;
            colp = a.in[kv ? 11 : 8] + (size_t)l * 2048 * 256 + (np & 255);
            dst = (bf16_t*)(ws + WS_CW1) + (size_t)l * 512 * 2048;
        } else {
            r -= 2 * (JA + JB) + JC + JD + JG;
            const int nb = r; K = 256; k0 = 0; n0 = nb * 128; ld = 64;
            const int np = n0 + 4 * c4, kv = np >> 8, within = np & 255;
            colp = within < 64 ? a.in[kv ? 12 : 9] + (size_t)l * 256 * 64 + within : nullptr;
            dst = (bf16_t*)(ws + WS_CW2) + (size_t)l * 512 * 256;
        }
        transpose_tile(colp, ld, K, dst, n0, k0, gk, lds, tid);
    }
    {
        bf16_t* XB = (bf16_t*)(ws + WS_H); float* SSP = (float*)(ws + WS_SSP);
        for (int m = gw; m < T; m += NGW) {
            const float* xr = a.in[0] + (size_t)m * D + 4 * lane;
            f32x4 v[4]; float ssum = 0.f;
            bf16_t* o = XB + (size_t)m * D + 4 * lane;
#pragma unroll
            for (int j = 0; j < 4; ++j) { v[j] = __builtin_nontemporal_load((const f32x4*)(xr + 256 * j));
                u32x2 w; w.x = pk2(v[j][0], v[j][1]); w.y = pk2(v[j][2], v[j][3]); *(u32x2*)(o + 256 * j) = w;
                const float r0 = bflo(w.x), r1 = bfhi(w.x), r2 = bflo(w.y), r3 = bfhi(w.y);
                ssum += (r0 * r0 + r1 * r1) + (r2 * r2 + r3 * r3); }
            ssum = wave_sum(ssum, lane);
            if (lane < 4) SSP[(size_t)m * 4 + lane] = lane == 0 ? ssum : 0.f;
        }
    }
    {
        float* PART = (float*)(ws + WS_BPART);
        for (int task = gw; task < NL * 2 * 4 * 64; task += NGW) {
            const int kc = task & 63, cg_ = (task >> 6) & 3, kv = (task >> 8) & 1, l = task >> 9;
            const int col = cg_ * 64 + lane;
            const float* pos = a.in[kv ? 10 : 7] + (size_t)l * 2048 + kc * 32;
            const float* w1 = a.in[kv ? 11 : 8] + (size_t)l * 2048 * 256 + (size_t)kc * 32 * 256 + col;
            float s0 = 0.f, s1 = 0.f, s2 = 0.f, s3 = 0.f;
#pragma unroll
            for (int k = 0; k < 32; k += 4) { s0 += pos[k] * w1[(size_t)k * 256]; s1 += pos[k + 1] * w1[(size_t)(k + 1) * 256]; s2 += pos[k + 2] * w1[(size_t)(k + 2) * 256]; s3 += pos[k + 3] * w1[(size_t)(k + 3) * 256]; }
            PART[kc * 2048 + (l * 2 + kv) * 256 + col] = (s0 + s1) + (s2 + s3);
        }
    }
}

__device__ __forceinline__ void norm_phase(const float* X, const float* gvec, bf16_t* H, const int tid, const int bid) {
    const int lane = tid & 63, wave = tid >> 6;
    const int gw = bid * 8 + wave, NGW = gridDim.x * 8;
    f32x4 gv[4];
#pragma unroll
    for (int j = 0; j < 4; ++j) gv[j] = *(const f32x4*)(gvec + 4 * lane + 256 * j);
    for (int m = gw; m < T; m += NGW) {
        const float* xr = X + (size_t)m * D + 4 * lane;
        f32x4 v[4]; float s = 0.f;
#pragma unroll
        for (int j = 0; j < 4; ++j) { v[j] = *(const f32x4*)(xr + 256 * j); s += (v[j][0] * v[j][0] + v[j][1] * v[j][1]) + (v[j][2] * v[j][2] + v[j][3] * v[j][3]); }
        const float r = rsqrtf(wave_sum(s, lane) * (1.f / D) + EPS);
        bf16_t* o = H + (size_t)m * D + 4 * lane;
#pragma unroll
        for (int j = 0; j < 4; ++j) { u32x2 w; w.x = pk2(v[j][0] * r * gv[j][0], v[j][1] * r * gv[j][1]); w.y = pk2(v[j][2] * r * gv[j][2], v[j][3] * r * gv[j][3]); *(u32x2*)(o + 256 * j) = w; }
    }
}
__device__ __forceinline__ void final_norm_phase(const bf16_t* XB, float* OUT, const float* gvec, const float* SSP, const int tid, const int bid) {
    const int lane = tid & 63, wave = tid >> 6;
    const int gw = bid * 8 + wave, NGW = gridDim.x * 8;
    f32x4 gv[4];
#pragma unroll
    for (int j = 0; j < 4; ++j) gv[j] = *(const f32x4*)(gvec + 4 * lane + 256 * j);
    for (int m0 = gw; m0 < T; m0 += 2 * NGW) {
        u32x2 w[2][4]; float r[2];
#pragma unroll
        for (int e = 0; e < 2; ++e) { const int m = m0 + e * NGW;
            if (m < T) { const bf16_t* xr = XB + (size_t)m * D + 4 * lane;
#pragma unroll
                for (int j = 0; j < 4; ++j) w[e][j] = __builtin_nontemporal_load((const u32x2*)(xr + 256 * j));
                r[e] = pg8::row_rscale(SSP, m); } }
#pragma unroll
        for (int e = 0; e < 2; ++e) { const int m = m0 + e * NGW;
            if (m < T) { float* o = OUT + (size_t)m * D + 4 * lane;
#pragma unroll
                for (int j = 0; j < 4; ++j) { const f32x4 v = {bflo(w[e][j].x), bfhi(w[e][j].x), bflo(w[e][j].y), bfhi(w[e][j].y)};
                    __builtin_nontemporal_store(v * r[e] * gv[j], (f32x4*)(o + 256 * j)); } } }
    }
}

__device__ __forceinline__ void conv_phase(const Args& a, unsigned char* ws, int l, LAS unsigned char* lds, const int tid, const int bid) {
    const int lane_outer = tid & 63, wave = tid >> 6;
    const int nskip = gridDim.x > 64 ? 64 : 0;
    if (bid < nskip) return;
    LAS float* wp = (LAS float*)lds;
    LAS unsigned char* rows = lds + 31 * 512 * 4;
    const float* cw = a.in[13] + (size_t)l * 31 * 512;
    {
        float wv[31];
#pragma unroll
        for (int j = 0; j < 31; ++j) wv[j] = cw[j * 512 + tid];
#pragma unroll
        for (int j = 0; j < 31; ++j) wp[j * 512 + tid] = wv[j];
    }
    const bf16_t* GLU = (const bf16_t*)(ws + WS_GLU);
    bf16_t* ATT = (bf16_t*)(ws + WS_ATT);
    const int nb = gridDim.x - nskip;
    for (int bt = bid - nskip; bt < T / 64; bt += nb) {
        const int R0 = bt * 64, tb0 = R0 & (SEQ - 1);
        __syncthreads();
        {
            int tq = tid; asm volatile("" : "+v"(tq));
            const int i0 = tq >> 6, ch = tq & 63;
            const bf16_t* gsrc = GLU + (size_t)(R0 - 30 + i0) * 512 + ch * 8;
            LAS unsigned char* ldst = rows + tq * 16;
            u32x4 v[12];
#pragma unroll
            for (int it = 0; it < 12; ++it) { const int i = i0 + 8 * it;
                v[it] = (i < 94 && tb0 - 30 + i >= 0) ? *(const u32x4*)(gsrc + (size_t)it * 8 * 512) : (u32x4){0u, 0u, 0u, 0u}; }
#pragma unroll
            for (int it = 0; it < 12; ++it) { if (i0 + 8 * it < 94) *(LAS u32x4*)(ldst + it * 8192) = v[it]; }
        }
        __syncthreads();
        int lane = lane_outer; asm volatile("" : "+v"(lane));
        const int cA = 4 * lane, cB = 256 + 4 * lane;
        const int row0 = R0 + 8 * wave;
        const LAS unsigned char* myrows = rows + (8 * wave) * 1024 + 8 * lane;
        f32x4 accA[8], accB[8];
#pragma unroll
        for (int tt = 0; tt < 8; ++tt) { accA[tt] = (f32x4){0.f, 0.f, 0.f, 0.f}; accB[tt] = (f32x4){0.f, 0.f, 0.f, 0.f}; }
        f32x4 FA[8], FB[8];
#pragma unroll
        for (int i = 0; i < 8; ++i) { const u32x2 ra = *(const LAS u32x2*)(myrows + i * 1024), rb = *(const LAS u32x2*)(myrows + i * 1024 + 512);
            FA[i] = (f32x4){bflo(ra.x), bfhi(ra.x), bflo(ra.y), bfhi(ra.y)}; FB[i] = (f32x4){bflo(rb.x), bfhi(rb.x), bflo(rb.y), bfhi(rb.y)}; }
#pragma unroll 1
        for (int jb = 0; jb < 32; jb += 8)
#pragma unroll
        for (int jj = 0; jj < 8; ++jj) {
            const int j = jb + jj;
            if (j >= 31) break;
            const LAS float* wr_ = wp + j * 512;
            const f32x4 wa = *(const LAS f32x4*)(wr_ + cA), wb = *(const LAS f32x4*)(wr_ + cB);
            u32x2 ra = {0u, 0u}, rb = {0u, 0u};
            if (j + 8 < 38) { ra = *(const LAS u32x2*)(myrows + (j + 8) * 1024); rb = *(const LAS u32x2*)(myrows + (j + 8) * 1024 + 512); }
#pragma unroll
            for (int tt = 0; tt < 8; ++tt) { accA[tt] += wa * FA[(jj + tt) & 7]; accB[tt] += wb * FB[(jj + tt) & 7]; }
            if (j + 8 < 38) {
                FA[jj & 7] = (f32x4){bflo(ra.x), bfhi(ra.x), bflo(ra.y), bfhi(ra.y)}; FB[jj & 7] = (f32x4){bflo(rb.x), bfhi(rb.x), bflo(rb.y), bfhi(rb.y)};
            }
            __builtin_amdgcn_sched_barrier(0);
        }
        const f32x4 biasA = *(const f32x4*)(a.in[14] + l * 512 + cA), biasB = *(const f32x4*)(a.in[14] + l * 512 + cB);
        const f32x4 lgA = *(const f32x4*)(a.in[15] + l * 512 + cA), lgB = *(const f32x4*)(a.in[15] + l * 512 + cB);
        const f32x4 lbA = *(const f32x4*)(a.in[16] + l * 512 + cA), lbB = *(const f32x4*)(a.in[16] + l * 512 + cB);
#pragma unroll
        for (int tt = 0; tt < 8; ++tt) {
            const f32x4 ya = accA[tt] + biasA, yb = accB[tt] + biasB;
            const float mu = wave_sum((ya[0] + ya[1]) + (ya[2] + ya[3]) + (yb[0] + yb[1]) + (yb[2] + yb[3]), lane) * (1.f / 512);
            const f32x4 da = ya - mu, db = yb - mu;
            const float var = wave_sum((da[0] * da[0] + da[1] * da[1]) + (da[2] * da[2] + da[3] * da[3]) + (db[0] * db[0] + db[1] * db[1]) + (db[2] * db[2] + db[3] * db[3]), lane) * (1.f / 512);
            const float rs = rsqrtf(var + EPS);
            const f32x4 za = da * rs * lgA + lbA, zb = db * rs * lgB + lbB;
            bf16_t* op = ATT + (size_t)(row0 + tt) * 1024 + 512;
            u32x2 w; w.x = pk2(fsilu(za[0]), fsilu(za[1])); w.y = pk2(fsilu(za[2]), fsilu(za[3])); *(u32x2*)(op + cA) = w;
            w.x = pk2(fsilu(zb[0]), fsilu(zb[1])); w.y = pk2(fsilu(zb[2]), fsilu(zb[3])); *(u32x2*)(op + cB) = w;
        }
    }
    __syncthreads();
}

constexpr int KPITCH = 72, VPITCH = 96;
constexpr int A_KBUF = 0, A_VBUF = 2 * 64 * KPITCH * 2;
constexpr int A_IMPA = A_VBUF + 2 * 64 * VPITCH * 2;
constexpr int IMPP = 65;
constexpr int A_IMPB = A_IMPA + 64 * IMPP * 4;
constexpr int A_SEL = A_IMPB + 64 * IMPP * 4;
constexpr int A_UNI = A_SEL + 512;
constexpr int A_OUT = A_UNI + 16;
constexpr int A_END = A_OUT + 32 * 512 * 4;
static_assert(A_END <= LDS_BYTES - 64, "attention LDS map");
static_assert(31 * 512 * 4 + 94 * 1024 <= LDS_BYTES - 64, "conv LDS map");

struct AttnState { float m, l; f32x16 o0, o1; };

template <int MODE  >
__device__ __forceinline__ void attn_pass(LAS unsigned char* lds, const bf16_t* Kg, const bf16_t* Vg  ,
                                          unsigned long long blockmask, const bf16x8 (&qf)[4], AttnState& st, int t, float slope2, unsigned long long selmask, int w, int lane_in, int tid_in, int cblk) {
    int lane = lane_in, tid = tid_in;
    asm volatile("" : "+v"(lane), "+v"(tid));
    constexpr bool NEEDV = (MODE != 3);
    constexpr bool CMPM = (MODE == 0 || MODE == 3);
    const int col = lane & 31, h = lane >> 5;
    const int skey = tid >> 3, schunk = tid & 7;
    unsigned long long rem = blockmask;
    if (!rem) return;
    int j = 63 - __builtin_clzll(rem); rem &= ~(1ull << j);
    u32x4 kreg, vreg;
    kreg = *(const u32x4*)(Kg + (size_t)(64 * j + skey) * 128 + schunk * 8);
    if (NEEDV) vreg = *(const u32x4*)(Vg + (size_t)(64 * j + skey) * 128 + schunk * 8);
    int cur = 0;
    {
        LAS bf16_t* kb = (LAS bf16_t*)(lds + A_KBUF) + cur * 64 * KPITCH;
        *(LAS u32x4*)(kb + skey * KPITCH + schunk * 8) = kreg;
        if (NEEDV) { LAS bf16_t* vb = (LAS bf16_t*)(lds + A_VBUF) + cur * 64 * VPITCH;
            *(LAS u32x4*)(vb + skey * VPITCH + schunk * 8) = vreg; }
    }
    __syncthreads();
    for (;;) {
        const bool has_next = rem != 0ull; int jn = 0;
        if (has_next) { jn = 63 - __builtin_clzll(rem); rem &= ~(1ull << jn);
            kreg = *(const u32x4*)(Kg + (size_t)(64 * jn + skey) * 128 + schunk * 8);
            if (NEEDV) vreg = *(const u32x4*)(Vg + (size_t)(64 * jn + skey) * 128 + schunk * 8); }
        const bool selbit = (MODE == 1) ? (((selmask >> j) & 1ull) != 0ull) : true;
        bool active = true;
        if (MODE == 1) active = __builtin_amdgcn_ballot_w64(selbit) != 0ull;
        if (active) {
            const LAS bf16_t* kb = (const LAS bf16_t*)(lds + A_KBUF) + cur * 64 * KPITCH;
            constexpr int STEP = CMPM ? 16 : 1;
            const int Bint = CMPM ? (1024 * j + 31 - t + 64 * h) : (64 * j - t + 4 * h);
            const float sl = slope2 * (float)STEP;
            const float mref = st.m; const bool fresh = !(mref > -1e28f);
            const float mest = fresh ? 0.f : mref;
            const float basef = selbit ? (slope2 * (float)Bint - mest) : -1e30f;
            int ptype;
            if (MODE == 1) ptype = (j == cblk) ? 1 : 0;
            else if (MODE == 2) ptype = (j == cblk) ? 1 : ((j == cblk - 8) ? 2 : 0);
            else ptype = (64 * j + 63 <= 4 * cblk - 2) ? 0 : 1;
            f32x16 s0, s1;
            { const float sl2 = sl + sl, sl3 = sl2 + sl;
#pragma unroll
              for (int g8 = 0; g8 < 4; ++g8) {
                  const float b0 = __builtin_fmaf(sl, (float)(8 * g8), basef), b1 = __builtin_fmaf(sl, (float)(8 * g8 + 32), basef);
                  s0[4 * g8] = b0; s0[4 * g8 + 1] = b0 + sl; s0[4 * g8 + 2] = b0 + sl2; s0[4 * g8 + 3] = b0 + sl3;
                  s1[4 * g8] = b1; s1[4 * g8 + 1] = b1 + sl; s1[4 * g8 + 2] = b1 + sl2; s1[4 * g8 + 3] = b1 + sl3;
              } }
            if (ptype == 1) {
                const float thr = 0.5f * slope2 - mest;
#pragma unroll
                for (int i = 0; i < 16; ++i) { s0[i] = (s0[i] < thr) ? s0[i] : -1e30f; s1[i] = (s1[i] < thr) ? s1[i] : -1e30f; }
            } else if (ptype == 2) {
                const float thr = -511.5f * slope2 - mest;
#pragma unroll
                for (int i = 0; i < 16; ++i) { s0[i] = (s0[i] > thr) ? s0[i] : -1e30f; s1[i] = (s1[i] > thr) ? s1[i] : -1e30f; }
            }
#pragma unroll
            for (int kk = 0; kk < 4; ++kk) {
                const bf16x8 k0 = *(const LAS bf16x8*)(kb + col * KPITCH + kk * 16 + h * 8);
                const bf16x8 k1 = *(const LAS bf16x8*)(kb + (32 + col) * KPITCH + kk * 16 + h * 8);
                s0 = __builtin_amdgcn_mfma_f32_32x32x16_bf16(k0, qf[kk], s0, 0, 0, 0);
                s1 = __builtin_amdgcn_mfma_f32_32x32x16_bf16(k1, qf[kk], s1, 0, 0, 0);
            }
            if (MODE != 3) {
                float mx = fmaxf(s0[0], s1[0]);
#pragma unroll
                for (int i = 1; i < 16; ++i) mx = fmaxf(mx, fmaxf(s0[i], s1[i]));
                mx = fmaxf(mx, shflx(mx, 32, lane));
                float alpha = 1.f;
                if (__builtin_amdgcn_ballot_w64(fresh || mx > 0.f) != 0ull) {
                    const float moldr = fresh ? -1e29f : 0.f, mnewr = fmaxf(moldr, mx);
                    alpha = __builtin_amdgcn_exp2f(moldr - mnewr);
                    st.m = mest + mnewr;
#pragma unroll
                    for (int i = 0; i < 16; ++i) { s0[i] = __builtin_amdgcn_exp2f(s0[i] - mnewr); s1[i] = __builtin_amdgcn_exp2f(s1[i] - mnewr); }
                    st.o0 *= alpha; st.o1 *= alpha;
                } else {
#pragma unroll
                    for (int i = 0; i < 16; ++i) { s0[i] = __builtin_amdgcn_exp2f(s0[i]); s1[i] = __builtin_amdgcn_exp2f(s1[i]); }
                }
                { typedef float f32x8 __attribute__((ext_vector_type(8)));
                  const f32x16 t16 = s0 + s1;
                  const f32x8 t8 = __builtin_shufflevector(t16, t16, 0, 1, 2, 3, 4, 5, 6, 7) + __builtin_shufflevector(t16, t16, 8, 9, 10, 11, 12, 13, 14, 15);
                  const f32x4 t4 = __builtin_shufflevector(t8, t8, 0, 1, 2, 3) + __builtin_shufflevector(t8, t8, 4, 5, 6, 7);
                  float ps = (t4[0] + t4[1]) + (t4[2] + t4[3]);
                  ps += shflx(ps, 32, lane);
                  st.l = st.l * alpha + ps; }
                bf16x8 pf[4];
#pragma unroll
                for (int kk = 0; kk < 4; ++kk) {
                    u32x4 pw;
                    if (kk < 2) { pw.x = pk2(s0[8 * kk], s0[8 * kk + 1]); pw.y = pk2(s0[8 * kk + 2], s0[8 * kk + 3]); pw.z = pk2(s0[8 * kk + 4], s0[8 * kk + 5]); pw.w = pk2(s0[8 * kk + 6], s0[8 * kk + 7]); }
                    else { const int k2 = kk - 2; pw.x = pk2(s1[8 * k2], s1[8 * k2 + 1]); pw.y = pk2(s1[8 * k2 + 2], s1[8 * k2 + 3]); pw.z = pk2(s1[8 * k2 + 4], s1[8 * k2 + 5]); pw.w = pk2(s1[8 * k2 + 6], s1[8 * k2 + 7]); }
                    pf[kk] = __builtin_bit_cast(bf16x8, pw);
                }
                const LAS bf16_t* vb = (const LAS bf16_t*)(lds + A_VBUF) + cur * 64 * VPITCH + (4 * h + ((lane & 15) >> 2)) * VPITCH + ((lane >> 4) & 1) * 16 + 4 * (lane & 3);
#pragma unroll
                for (int kk = 0; kk < 4; ++kk) {
                    typedef short v4i16_t __attribute__((ext_vector_type(4)));
                    const v4i16_t a0 = __builtin_amdgcn_ds_read_tr16_b64_v4i16((LAS v4i16_t*)(vb + (16 * kk) * VPITCH));
                    const v4i16_t a1 = __builtin_amdgcn_ds_read_tr16_b64_v4i16((LAS v4i16_t*)(vb + (16 * kk + 8) * VPITCH));
                    const v4i16_t b0 = __builtin_amdgcn_ds_read_tr16_b64_v4i16((LAS v4i16_t*)(vb + (16 * kk) * VPITCH + 32));
                    const v4i16_t b1 = __builtin_amdgcn_ds_read_tr16_b64_v4i16((LAS v4i16_t*)(vb + (16 * kk + 8) * VPITCH + 32));
                    const bf16x8 va = __builtin_shufflevector(a0, a1, 0, 1, 2, 3, 4, 5, 6, 7), vb8 = __builtin_shufflevector(b0, b1, 0, 1, 2, 3, 4, 5, 6, 7);
                    st.o0 = __builtin_amdgcn_mfma_f32_32x32x16_bf16(va, pf[kk], st.o0, 0, 0, 0);
                    st.o1 = __builtin_amdgcn_mfma_f32_32x32x16_bf16(vb8, pf[kk], st.o1, 0, 0, 0);
                }
            } else {
                const float inv = st.l > 0.f ? 1.f / st.l : 0.f;
                LAS float* impA = (LAS float*)(lds + A_IMPA); LAS float* impB = (LAS float*)(lds + A_IMPB);
                const int q = 8 * w + (col & 7);
#pragma unroll
                for (int kt = 0; kt < 2; ++kt)
#pragma unroll
                    for (int gi = 0; gi < 4; ++gi) {
                        float p[4];
#pragma unroll
                        for (int e = 0; e < 4; ++e) { const int i = 4 * gi + e; const float sv = kt ? s1[i] : s0[i]; p[e] = __builtin_amdgcn_exp2f(sv) * inv; }
                        float av = (p[0] + p[1]) + (p[2] + 0.5f * p[3]), bv = 0.5f * p[3];
                        av += shflx(av, 8, lane); av += shflx(av, 16, lane);
                        bv += shflx(bv, 8, lane); bv += shflx(bv, 16, lane);
                        const int jj = 16 * j + 8 * kt + 2 * gi + h;
                        if (col < 8 && jj < 64) { impA[q * IMPP + jj] = av; if (jj + 1 < 64) impB[q * IMPP + jj + 1] = bv; }
                    }
            }
        }
        if (has_next) {
            LAS bf16_t* kb = (LAS bf16_t*)(lds + A_KBUF) + (cur ^ 1) * 64 * KPITCH;
            *(LAS u32x4*)(kb + skey * KPITCH + schunk * 8) = kreg;
            if (NEEDV) { LAS bf16_t* vb = (LAS bf16_t*)(lds + A_VBUF) + (cur ^ 1) * 64 * VPITCH;
                *(LAS u32x4*)(vb + skey * VPITCH + schunk * 8) = vreg; }
        }
        __syncthreads();
        if (!has_next) break;
        j = jn; cur ^= 1;
    }
}

__device__ __forceinline__ void attn_unit(unsigned char* ws, LAS unsigned char* lds, int b, int g, int c, const int tid) {
    const int lane = tid & 63, w = tid >> 6, col = lane & 31, h = lane >> 5, r = col >> 3, qi = col & 7;
    const int q = 8 * w + qi, t = 64 * c + q, head = g * 4 + r;
    const size_t row = (size_t)b * SEQ + t;
    const float slope2 = exp2f(-(float)(head + 1)) * LOG2E;
    const bf16_t* Qp = (const bf16_t*)(ws + WS_Q) + row * 512 + head * 64 + 8 * h;
    bf16x8 qf[4];
#pragma unroll
    for (int kk = 0; kk < 4; ++kk) qf[kk] = *(const bf16x8*)(Qp + 16 * kk);
    for (int i = tid; i < 2 * 64 * IMPP; i += 512) ((LAS float*)(lds + A_IMPA))[i] = 0.f;
    LAS float* outl = (LAS float*)(lds + A_OUT) + tid;
    const size_t boff = (size_t)b * SEQ * 128 + g * 64;
    const int nvalid = 4 * c + 3 > 255 ? 255 : 4 * c + 3;
    const int nkb = (nvalid + 63) >> 6;
    const unsigned long long cmpmask = (nkb >= 64) ? ~0ull : ((1ull << nkb) - 1ull);
    const bf16_t* KCp = (const bf16_t*)(ws + WS_KC) + (size_t)b * 256 * 128 + g * 64;
    const bf16_t* VCp = (const bf16_t*)(ws + WS_VC) + (size_t)b * 256 * 128 + g * 64;
    AttnState st; st.m = -1e29f; st.l = 0.f; st.o0 = (f32x16){}; st.o1 = (f32x16){};
    attn_pass<0>(lds, KCp, VCp, cmpmask, qf, st, t, slope2, 0ull, w, lane, tid, c);
    { const float gate0 = ((const float*)(ws + WS_G))[row * 32 + head * 3 + 0]; const float sc = st.l > 0.f ? gate0 / st.l : 0.f;
#pragma unroll
      for (int i = 0; i < 16; ++i) { outl[i * 512] = st.o0[i] * sc; outl[(16 + i) * 512] = st.o1[i] * sc; } }
    unsigned long long selmask, unionmask;
    if (c >= 16) {
        attn_pass<3>(lds, KCp, VCp, cmpmask, qf, st, t, slope2, 0ull, w, lane, tid, c);
        LAS float* impA = (LAS float*)(lds + A_IMPA); LAS float* impB = (LAS float*)(lds + A_IMPB);
        int tidk = tid; asm volatile("" : "+v"(tidk));
        for (int i = tidk; i < 64 * 64; i += 512) { const int qq = i >> 6, jj = i & 63; impA[qq * IMPP + jj] += impB[qq * IMPP + jj]; }
        __syncthreads();
        {
            const int qq = tidk >> 3, jg = tidk & 7;
            float mine[8]; int rank[8];
#pragma unroll
            for (int e = 0; e < 8; ++e) { mine[e] = impA[qq * IMPP + 8 * jg + e]; rank[e] = 0; }
            for (int jp = 1; jp <= c - 2; ++jp) {
                const float v = impA[qq * IMPP + jp];
#pragma unroll
                for (int e = 0; e < 8; ++e) { const int jm = 8 * jg + e; rank[e] += (v > mine[e] || (v == mine[e] && jp < jm)) ? 1 : 0; }
            }
            unsigned bits = 0;
#pragma unroll
            for (int e = 0; e < 8; ++e) { const int jm = 8 * jg + e; const bool cand = jm >= 1 && jm <= c - 2; const bool forced = jm == 0 || jm == c || jm == c - 1;
                if (forced || (cand && rank[e] < 13)) bits |= 1u << e; }
            ((LAS unsigned char*)(lds + A_SEL))[qq * 8 + jg] = (unsigned char)bits;
        }
        __syncthreads();
        if (w == 0) {
            const u32x2 mm = *(const LAS u32x2*)(lds + A_SEL + lane * 8);
            unsigned lo = mm.x, hi = mm.y;
#pragma unroll
            for (int o = 1; o < 64; o <<= 1) { lo |= shflxu(lo, o, lane); hi |= shflxu(hi, o, lane); }
            if (lane == 0) { *(LAS u32x2*)(lds + A_UNI) = (u32x2){lo, hi}; }
        }
        __syncthreads();
        { const u32x2 mm = *(const LAS u32x2*)(lds + A_SEL + q * 8); selmask = ((unsigned long long)mm.y << 32) | mm.x;
          const u32x2 uu = *(const LAS u32x2*)(lds + A_UNI); unionmask = ((unsigned long long)uu.y << 32) | uu.x; }
    } else {
        selmask = (1ull << (c + 1)) - 1ull; unionmask = selmask;
    }
    st.m = -1e29f; st.l = 0.f; st.o0 = (f32x16){}; st.o1 = (f32x16){};
    attn_pass<1>(lds, (const bf16_t*)(ws + WS_KS) + boff, (const bf16_t*)(ws + WS_VS) + boff, unionmask, qf, st, t, slope2, selmask, w, lane, tid, c);
    { const float gate1 = ((const float*)(ws + WS_G))[row * 32 + head * 3 + 1]; const float sc = st.l > 0.f ? gate1 / st.l : 0.f;
#pragma unroll
      for (int i = 0; i < 16; ++i) { outl[i * 512] += st.o0[i] * sc; outl[(16 + i) * 512] += st.o1[i] * sc; } }
    st.m = -1e29f; st.l = 0.f; st.o0 = (f32x16){}; st.o1 = (f32x16){};
    { const int jlo = c >= 8 ? c - 8 : 0; const unsigned long long upto = (c >= 63) ? ~0ull : ((1ull << (c + 1)) - 1ull);
      const unsigned long long winmask = upto & ~((1ull << jlo) - 1ull);
      attn_pass<2>(lds, (const bf16_t*)(ws + WS_KW) + boff, (const bf16_t*)(ws + WS_VW) + boff, winmask, qf, st, t, slope2, 0ull, w, lane, tid, c); }
    { const float gate2 = ((const float*)(ws + WS_G))[row * 32 + head * 3 + 2]; const float sc = st.l > 0.f ? gate2 / st.l : 0.f;
#pragma unroll
      for (int i = 0; i < 16; ++i) { st.o0[i] = outl[i * 512] + st.o0[i] * sc; st.o1[i] = outl[(16 + i) * 512] + st.o1[i] * sc; } }
    bf16_t* op = (bf16_t*)(ws + WS_ATT) + row * 1024 + head * 64 + 4 * h;
#pragma unroll
    for (int gi = 0; gi < 4; ++gi) {
        u32x2 w0; w0.x = pk2(st.o0[4 * gi], st.o0[4 * gi + 1]); w0.y = pk2(st.o0[4 * gi + 2], st.o0[4 * gi + 3]); *(u32x2*)(op + 8 * gi) = w0;
        u32x2 w1; w1.x = pk2(st.o1[4 * gi], st.o1[4 * gi + 1]); w1.y = pk2(st.o1[4 * gi + 2], st.o1[4 * gi + 3]); *(u32x2*)(op + 32 + 8 * gi) = w1;
    }
}

__device__ __forceinline__ void attn_phase(unsigned char* ws, LAS unsigned char* lds, const int tid, const int bid, const int l) {
    unsigned* ctr = (unsigned*)(ws + WS_CTL) + 3584 + 64 * l;
    volatile LAS int* slot = (volatile LAS int*)(lds + LDS_MISC + 48);
    if (tid == 0) slot[0] = (int)__hip_atomic_fetch_add(ctr, 1u, __ATOMIC_RELAXED, __HIP_MEMORY_SCOPE_AGENT);
    __syncthreads();
    int u = slot[0];
    while (u < 1024) {
        __syncthreads();
        if (tid == 0) slot[0] = (int)__hip_atomic_fetch_add(ctr, 1u, __ATOMIC_RELAXED, __HIP_MEMORY_SCOPE_AGENT);
        int b, g, c;
        if (u < 384) { g = 1; c = 63 - (u >> 3); b = u & 7; }
        else if (u < 768) { const int v = u - 384; g = 0; c = 63 - (v >> 3); b = v & 7; }
        else { const int v = u - 768; c = 15 - (v >> 4); g = (v >> 3) & 1; b = v & 7; }
        attn_unit(ws, lds, b, g, c, tid);
        __syncthreads();
        u = slot[0];
    }
}

#define XB_TMO      128
#define XB_XCNT(j)  (256  + 64 * (j))
#define XB_XSUB(j)  (1280 + 64 * (j))
#define XB_XGEN(j)  (2304 + 64 * (j))
#define XB_TOP      3328
#define XB_TOPGEN   3392
#define XCD_BAR_WORDS 3456
#define XB_SPIN_CAP (1u << 18)
__device__ __forceinline__ unsigned xb_ld(unsigned* p)              { return __hip_atomic_load(p, __ATOMIC_RELAXED, __HIP_MEMORY_SCOPE_AGENT); }
__device__ __forceinline__ unsigned xb_add(unsigned* p, unsigned v) { return __hip_atomic_fetch_add(p, v, __ATOMIC_RELAXED, __HIP_MEMORY_SCOPE_AGENT); }
__device__ __forceinline__ unsigned xb_xcc_id() { return (unsigned)__builtin_amdgcn_s_getreg((3 << 11) | 20) & 0xFu; }
#define XB_SPIN(cond, bar) do { unsigned _sp = 0; while (cond) { __builtin_amdgcn_s_sleep(1); \
    if ((++_sp & 255u) == 0u) { if (xb_ld(&(bar)[XB_TMO])) break; if (_sp > XB_SPIN_CAP) { atomicAdd(&(bar)[XB_TMO], 1u); break; } } } } while (0)
struct XcdBarrier { unsigned* bar; unsigned x; volatile LAS unsigned* st; };
__device__ __forceinline__ XcdBarrier xcd_barrier_post(unsigned* bar, volatile LAS unsigned* st) {
    XcdBarrier b; b.bar = bar; b.x = xb_xcc_id(); b.st = st;
    if (threadIdx.x == 0) (void)xb_add(&bar[XB_XCNT(b.x)], 1u);
    return b;
}
__device__ __forceinline__ void xcd_barrier_complete(unsigned* bar, unsigned x, unsigned& nloc, unsigned& nx) {
    const unsigned G = gridDim.x * gridDim.y * gridDim.z;
    unsigned sum, cnt, mine, sp = 0u;
    for (;;) {
        sum = 0u; cnt = 0u; mine = 0u;
#pragma unroll
        for (unsigned j = 0; j < 16; ++j) { const unsigned c = xb_ld(&bar[XB_XCNT(j)]); sum += c; cnt += (c > 0u) ? 1u : 0u; mine = (j == x) ? c : mine; }
        if (sum == G) break;
        __builtin_amdgcn_s_sleep(1);
        if ((++sp & 255u) == 0u) { if (xb_ld(&bar[XB_TMO])) break; if (sp > XB_SPIN_CAP) { atomicAdd(&bar[XB_TMO], 1u); break; } }
    }
    nloc = mine > 0u ? mine : 1u; nx = cnt > 0u ? cnt : 1u;
}
__device__ __forceinline__ void xcd_barrier(unsigned* bar_, volatile LAS unsigned* st_) {
    asm volatile("s_waitcnt vmcnt(0)" ::: "memory");
    __syncthreads();
    if (threadIdx.x == 0) {
        XcdBarrier b; b.bar = bar_; b.x = xb_xcc_id(); b.st = st_;
        unsigned* bar = b.bar;
        __builtin_amdgcn_s_waitcnt(0);
        unsigned nloc = b.st[0], nx = b.st[1];
        if (nloc == 0u) { xcd_barrier_complete(bar, b.x, nloc, nx); b.st[0] = nloc; b.st[1] = nx; }
        const unsigned old = xb_add(&bar[XB_XSUB(b.x)], 1u);
        const unsigned gen = old / nloc;
        if (old + 1u == (gen + 1u) * nloc) {
            __builtin_amdgcn_fence(__ATOMIC_RELEASE, "agent");
            asm volatile("s_waitcnt vmcnt(0)" ::: "memory");
            const unsigned og = xb_add(&bar[XB_TOP], 1u);
            const unsigned tg = og / nx;
            if (og + 1u == (tg + 1u) * nx) xb_add(&bar[XB_TOPGEN], 1u);
            else XB_SPIN(xb_ld(&bar[XB_TOPGEN]) == tg, bar);
            __builtin_amdgcn_fence(__ATOMIC_ACQUIRE, "agent");
            xb_add(&bar[XB_XGEN(b.x)], 1u);
            asm volatile("s_waitcnt vmcnt(0)" ::: "memory");
        } else {
            XB_SPIN(xb_ld(&bar[XB_XGEN(b.x)]) == gen, bar);
            __builtin_amdgcn_fence(__ATOMIC_ACQUIRE, "agent");
            asm volatile("s_waitcnt vmcnt(0)" ::: "memory");
        }
    }
    __syncthreads();
}

__global__ void __launch_bounds__(512, 2) fwd_megakernel(Args a_) {
    extern __shared__ __attribute__((aligned(16))) unsigned char lds_raw[];
    LAS unsigned char* lds = (LAS unsigned char*)lds_raw;
    cg::grid_group grid = cg::this_grid();
    const int G = gridDim.x;
        if (threadIdx.x < 8) ((LAS unsigned*)(lds + LDS_MISC))[threadIdx.x] = 0u;
    __syncthreads();
    (void)xcd_barrier_post((unsigned*)(a_.ws + WS_CTL), (volatile LAS unsigned*)(lds + LDS_MISC));
    for (int ph2 = 2 * a_.ph_lo; ph2 < 2 * a_.ph_hi; ++ph2) {
        const int ph = ph2 >> 1;
        if (ph >= 1 && ph <= 12 * NL) { const int kq = (ph - 1) % 12; if (kq == 0 || kq == 3 || kq == 6 || kq == 9) continue; }
        if (ph2 & 1) { const bool dup = (ph >= 1 && ph <= 12 * NL && ((DUP_K >> ((ph - 1) % 12)) & 1)) || (ph == 0 && (DUP_K & 0x1000)); if (!dup) continue; }
        int tid = threadIdx.x, bid = blockIdx.x;
        asm volatile("" : "+v"(tid));
        asm volatile("" : "+s"(bid));
        unsigned char* ws = a_.ws; asm volatile("" : "+s"(ws));
        const Args& a = a_;
        bf16_t* H = (bf16_t*)(ws + WS_H); bf16_t* U = (bf16_t*)(ws + WS_U);
        if (ph == 0) {
            if (EN_P0) p0_phase(a, ws, lds, tid, bid);
        } else if (ph == 1 + 12 * NL) {
            final_norm_phase(H, a.out, a.in[22], (const float*)(ws + WS_SSP), tid, bid);
        } else {
            const int l = (ph - 1) / 12, k0_ = (ph - 1) % 12; const int k = ((EN_K >> k0_) & 1) ? k0_ : 99;
            const bf16_t* wl = (const bf16_t*)(ws + WS_W) + (size_t)l * W_LAYER;
            if (k == 1 || k == 10) {
                if (ph == 2) { const int gt = bid * 512 + tid; if (gt < 2048) { const float* PART = (const float*)(ws + WS_BPART); float sacc = 0.f;
#pragma unroll
                    for (int c = 0; c < 64; ++c) sacc += PART[c * 2048 + gt];
                    ((float*)(ws + WS_BIAS1))[gt] = sacc; } }
                pg8::Gemm g{H, wl + (k == 1 ? OFF_SW1 : OFF_SW2), T, 2 * FF, D, D}; pg8::StaticOrder S; S.init(T, 2 * FF, G, bid);
                if ((tid & 63) == 0) ((LAS int*)(lds + 139264))[tid >> 6] = -1;
                pg8::EpiSwiglu E{U, (const float*)(ws + WS_SSP), (LAS float*)(lds + 135168), (LAS int*)(lds + 139264), ph * 256 + 1}; pg8::gemm_phase(lds, g, S, E, tid);
            } else if (k == 2 || k == 11 || k == 8) {
                const bool wo = (k == 8); const int Kd = wo ? D : FF;
                pg8::Gemm g{wo ? (const bf16_t*)(ws + WS_ATT) : U, wl + (k == 2 ? OFF_DN1 : (k == 11 ? OFF_DN2 : OFF_WOUT)), T, D, Kd, Kd}; pg8::StaticOrder S; S.init(T, D, G, bid);
                pg8::EpiResid E{H, (float*)(ws + WS_SSP), wo ? 1.0f : 0.5f, (LAS float*)(lds + 131072)}; pg8::gemm_phase(lds, g, S, E, tid);
            } else if (k == 4) {
                pg8::Gemm g{H, wl + OFF_WIN, T, 2048, D, D}; pg8::StaticOrder S; S.init(T, 2048, G, bid);
                if ((tid & 63) == 0) ((LAS int*)(lds + 139264))[tid >> 6] = -1;
                pg8::EpiWinT<0> E{ws, (LAS float*)(lds + 135168), (LAS int*)(lds + 139264), ph * 256 + 1}; pg8::gemm_phase(lds, g, S, E, tid);
            } else if (k == 5) {
                { pg8::Gemm g{(const bf16_t*)(ws + WS_KCMP), (const bf16_t*)(ws + WS_CW1) + (size_t)l * 512 * 2048, 8192, 512, 2048, 1024}; pg8::CmpOrder S{G, bid};
                  pg8::EpiCmp1 E{(bf16_t*)(ws + WS_HID), (const float*)(ws + WS_BIAS1) + l * 512}; pg8::gemm_phase(lds, g, S, E, tid); }
                if (bid < 32) {
                    asm volatile("s_waitcnt vmcnt(0)" ::: "memory");
                    __builtin_amdgcn_fence(__ATOMIC_RELEASE, "agent");
                    asm volatile("s_waitcnt vmcnt(0)" ::: "memory");
                    __syncthreads();
                    __builtin_amdgcn_fence(__ATOMIC_ACQUIRE, "agent");
                    asm volatile("s_waitcnt vmcnt(0)" ::: "memory");
                    __syncthreads();
                    pg8::Gemm g{(const bf16_t*)(ws + WS_HID), (const bf16_t*)(ws + WS_CW2) + (size_t)l * 512 * 256, 8192, 512, 256, 256}; pg8::CmpOrder S{G, bid};
                    pg8::EpiCmp2 E{(bf16_t*)(ws + WS_KC), (bf16_t*)(ws + WS_VC)}; pg8::gemm_phase(lds, g, S, E, tid);
                }
                __syncthreads();
                {
                    pg8::Gemm g{H, wl + OFF_WIN + (size_t)2048 * D, T, 512, D, D}; pg8::AuxOrder S{bid - 32};
                    if ((tid & 63) == 0) ((LAS int*)(lds + 139264))[tid >> 6] = -1;
                    pg8::EpiWinT<8> E{ws, (LAS float*)(lds + 135168), (LAS int*)(lds + 139264), ph * 256 + 1}; pg8::gemm_phase(lds, g, S, E, tid);
                }
                __syncthreads();
                if (EN_CONV) conv_phase(a, ws, l, lds, tid, bid);
            } else if (k == 7) { if (EN_ATTN) attn_phase(ws, lds, tid, bid, l); }
        }
        if (ph2 + 1 < 2 * a_.ph_hi) { if (a_.ph_hi < 0) grid.sync();   xcd_barrier((unsigned*)(ws + WS_CTL), (volatile LAS unsigned*)(lds + LDS_MISC)); for (int e = 0; e < DUP_SYNC; ++e) xcd_barrier((unsigned*)(ws + WS_CTL), (volatile LAS unsigned*)(lds + LDS_MISC)); }
    }
}

extern "C" void kernel_launch(void* const* d_in, const int* in_sizes, int n_in, void* d_out, int out_size, void* d_ws, size_t ws_size, hipStream_t stream) {
    static int grid = 0;
    if (grid == 0) {
        if (n_in != 23 || out_size != T * D || ws_size < WS_END) { fprintf(stderr, "kernel_launch: unexpected shapes (n_in %d out %d ws %zu)\n", n_in, out_size, ws_size); grid = -1; return; }
        int dev = 0, cus = 0, per_cu = 0;
        (void)hipGetDevice(&dev);
        (void)hipDeviceGetAttribute(&cus, hipDeviceAttributeMultiprocessorCount, dev);
        (void)hipFuncSetAttribute((const void*)fwd_megakernel, hipFuncAttributeMaxDynamicSharedMemorySize, LDS_BYTES);
        (void)hipOccupancyMaxActiveBlocksPerMultiprocessor(&per_cu, (const void*)fwd_megakernel, 512, LDS_BYTES);
        (void)hipGetLastError();
        grid = cus > 0 ? cus : 256;
    }
    if (grid < 0) return;
    if (hipMemsetAsync((char*)d_ws + WS_CTL, 0, CTL_BYTES, stream) != hipSuccess) { fprintf(stderr, "kernel_launch: memset of the barrier words failed\n"); return; }
    Args a{};
    for (int i = 0; i < 23; ++i) a.in[i] = (const float*)d_in[i];
    a.out = (float*)d_out; a.ws = (unsigned char*)d_ws; a.ph_lo = 0; a.ph_hi = 2 + 12 * NL;
    void* args[] = {&a};
    hipError_t e = hipLaunchCooperativeKernel((const void*)fwd_megakernel, dim3(grid), dim3(512), args, LDS_BYTES, stream);
    if (e != hipSuccess) fprintf(stderr, "cooperative launch failed: %s (grid %d)\n", hipGetErrorString(e), grid);
}
```

```cpp
#include <hip/hip_runtime.h>
#include <hip/hip_cooperative_groups.h>
#include <cstdio>
#include <cstdint>
namespace cg = cooperative_groups;
#ifndef EN_K
#define EN_K 0xfff
#endif
#ifndef DUP_K
#define DUP_K 0
#endif
#ifndef DUP_SYNC
#define DUP_SYNC 0
#endif
#ifndef EN_ATTN
#define EN_ATTN 1
#endif
#ifndef EN_CONV
#define EN_CONV 1
#endif
#ifndef EN_P0
#define EN_P0 1
#endif


#define LAS __attribute__((address_space(3)))
typedef unsigned short bf16_t;
typedef short bf16x8 __attribute__((ext_vector_type(8)));
typedef short s16x4 __attribute__((ext_vector_type(4)));
typedef float f32x4 __attribute__((ext_vector_type(4)));
typedef float f32x16 __attribute__((ext_vector_type(16)));
typedef unsigned u32x4 __attribute__((ext_vector_type(4)));
typedef unsigned u32x2 __attribute__((ext_vector_type(2)));
typedef float f32x2_t __attribute__((ext_vector_type(2)));
typedef __bf16 bf16x2_t __attribute__((ext_vector_type(2)));

__device__ __forceinline__ unsigned pk2(float lo, float hi) { f32x2_t v = {lo, hi}; bf16x2_t b = __builtin_convertvector(v, bf16x2_t); return __builtin_bit_cast(unsigned, b); }
__device__ __forceinline__ float bf2f(unsigned short u) { return __builtin_bit_cast(float, ((unsigned)u) << 16); }
__device__ __forceinline__ float bflo(unsigned u) { return __builtin_bit_cast(float, u << 16); }
__device__ __forceinline__ float bfhi(unsigned u) { return __builtin_bit_cast(float, u & 0xffff0000u); }
__device__ __forceinline__ float fsigmoid(float x) { return __builtin_amdgcn_rcpf(1.0f + __expf(-x)); }
__device__ __forceinline__ float fsilu(float x) { return x * fsigmoid(x); }
__device__ __forceinline__ float shflx(float v, int mask, int lane) { return __builtin_bit_cast(float, __builtin_amdgcn_ds_bpermute(((lane ^ mask) & 63) << 2, __builtin_bit_cast(int, v))); }
__device__ __forceinline__ unsigned shflxu(unsigned v, int mask, int lane) { return (unsigned)__builtin_amdgcn_ds_bpermute(((lane ^ mask) & 63) << 2, (int)v); }
__device__ __forceinline__ float wave_sum(float v, int lane) {
#pragma unroll
    for (int o = 1; o < 64; o <<= 1) v += shflx(v, o, lane);
    return v;
}

constexpr int NB = 8, SEQ = 4096, T = NB * SEQ, D = 1024, FF = 2816, NL = 4, INW = 2328;
constexpr float EPS = 1e-6f;
constexpr float LOG2E = 1.4426950408889634f;

constexpr size_t MiB = 1u << 20;
constexpr size_t WS_W = 0;
constexpr size_t W_LAYER = 20971520;
constexpr size_t OFF_SW1 = 0, OFF_DN1 = 5767168, OFF_WIN = 8650752, OFF_WOUT = 11272192, OFF_SW2 = 12320768, OFF_DN2 = 18087936;
constexpr size_t WS_CW1 = 160 * MiB;
constexpr size_t WS_CW2 = 168 * MiB;
constexpr size_t WS_BIAS1 = 169 * MiB;
constexpr size_t WS_H = 170 * MiB;
constexpr size_t WS_U = 234 * MiB;
constexpr size_t WS_Q = 234 * MiB;
constexpr size_t WS_KS = 266 * MiB, WS_VS = 274 * MiB, WS_KW = 282 * MiB, WS_VW = 290 * MiB;
constexpr size_t WS_KCMP = 298 * MiB;
constexpr size_t WS_GLU = 314 * MiB;
constexpr size_t WS_ATT = 346 * MiB;
constexpr size_t WS_G = 410 * MiB;
constexpr size_t WS_HID = 414 * MiB;
constexpr size_t WS_KC = 418 * MiB;
constexpr size_t WS_VC = WS_KC + 512 * 1024;
constexpr size_t WS_CTL = 420 * MiB;
constexpr size_t CTL_BYTES = 16384;
constexpr size_t WS_SSP = 421 * MiB;
constexpr size_t WS_BPART = 423 * MiB;
constexpr size_t WS_END = 424 * MiB;

constexpr int LDS_BYTES = 163840;
constexpr int LDS_MISC = LDS_BYTES - 64;

namespace pg8 {
constexpr int BM = 256, BK = 64, HALF = 128, HTB = HALF * BK * 2, STAGE_BYTES = 8 * HTB, NXCD = 8, WGM = 8;
__host__ __device__ __forceinline__ int lds_byte(int r, int c) { const int st = (r >> 4) * 2 + (c >> 5), rr = r & 15, cc = c & 31, ob = rr * 64 + cc * 2; return st * 1024 + (ob ^ (((ob >> 9) & 1) << 5)); }
__host__ __device__ __forceinline__ void stage_rc(int b, int& R, int& C) { const int st = b / 1024, sb = b % 1024, swz = sb ^ (((sb >> 9) & 1) << 5); R = (st >> 1) * 16 + swz / 64; C = (st & 1) * 32 + (swz % 64) / 2; }
__host__ __device__ __forceinline__ int perm32(int rho) { const int n = rho >> 4, i = rho & 15; return 8 * (i >> 2) + 4 * n + (i & 3); }
struct Unit { int pm, pn; };
struct Gemm { const bf16_t* A; const bf16_t* Bt; int M, N, K, lda; };
struct StaticOrder {
    int nM, nN, nwg, G, c;
    __host__ __device__ void init(int M, int N, int G_, int c_) { nM = M / BM; nN = N / BM; nwg = nM * nN; G = G_; c = c_; }
    __host__ __device__ bool next(int i, Unit& u) const {
        const long L = (long)i * G + c; if (L >= nwg) return false;
        int wgid = (int)L; { const int q = nwg / NXCD, r = nwg % NXCD, xcd = wgid % NXCD, off = wgid / NXCD; wgid = (xcd < r ? xcd * (q + 1) : r * (q + 1) + (xcd - r) * q) + off; }
        const int nig = WGM * nN, gid = wgid / nig, fm = gid * WGM, gsz = (nM - fm) < WGM ? (nM - fm) : WGM;
        u.pm = fm + ((wgid % nig) % gsz); u.pn = (wgid % nig) / gsz; return true;
    }
};
struct AuxOrder {
    int j;
    __host__ __device__ bool next(int i, Unit& u) const {
        int v;
        if (j < 0) return false;
        if (j < 32) { if (i >= 2) return false; v = 2 * j + i; u.pm = v >> 1; u.pn = v & 1; return true; }
        if (i >= 1 || j >= 224) return false;
        const int jj = j - 32, grp = jj >> 4, within = jj & 15;
        u.pm = 32 + grp * 8 + (within & 7); u.pn = within >> 3; return true;
    }
};
struct CmpOrder {
    int G, c;
    __host__ __device__ bool next(int i, Unit& u) const { const int L = i * G + c; if (L >= 32) return false; u.pm = L; u.pn = L >> 4; return true; }
};

template <class Epi, class Sched>
__device__ __forceinline__ void gemm_phase(LAS unsigned char* lds, const Gemm g, const Sched S, const Epi E, const int tid) {
    const int wid = __builtin_amdgcn_readfirstlane(tid >> 6), lane = tid & 63, wr = wid >> 2, wc = wid & 3, fr = lane & 15, fq = lane >> 4;
    const int K = g.K, nt = K / BK, lda = g.lda;
    unsigned voffA[2], voffB[2];
#pragma unroll
    for (int i = 0; i < 2; ++i) { int R, C; stage_rc(tid * 16 + i * 8192, R, C); const int Rb = Epi::PERM ? ((R & ~31) + perm32(R & 31)) : R;
        voffA[i] = (unsigned)(R * lda + C) * 2u; voffB[i] = (unsigned)(Rb * K + C) * 2u; }
    const size_t kstep = (size_t)(BK * 2);
    const size_t hstepA = (size_t)HALF * lda * 2, hstepB = (size_t)HALF * K * 2;
    const size_t tstepA = 2 * hstepA, tstepB = 2 * hstepB;
    const unsigned ldsw = (unsigned)wid * 1024u;
    const int aoff = lds_byte(wr * 64 + fr, fq * 8), boff = lds_byte(wc * 32 + fr, fq * 8);
#define PG8_SA(b, h) (((b) * 2 + (h)) * HTB)
#define PG8_SB(b, h) ((4 + (b) * 2 + (h)) * HTB)
#define PG8_STAGE(bufoff, gbase, voff) do { _Pragma("unroll") for (int _i = 0; _i < 2; ++_i) \
        __builtin_amdgcn_global_load_lds((const unsigned*)((const char*)(gbase) + (voff)[_i]), (LAS unsigned*)(lds + (bufoff) + ldsw + _i * 8192), 16, 0, 0); } while (0)
#define PG8_LDA(dst, b, h) do { _Pragma("unroll") for (int m = 0; m < 4; ++m) _Pragma("unroll") for (int k = 0; k < 2; ++k) dst[m][k] = *(const LAS bf16x8*)(lds + PG8_SA(b, h) + aoff + m * 2048 + k * 1024); } while (0)
#define PG8_LDB(dst, b, h) do { _Pragma("unroll") for (int n = 0; n < 2; ++n) _Pragma("unroll") for (int k = 0; k < 2; ++k) dst[n][k] = *(const LAS bf16x8*)(lds + PG8_SB(b, h) + boff + n * 2048 + k * 1024); } while (0)
#define PG8_MMA(ai, bj, At, Bt) do { __builtin_amdgcn_s_setprio(1); _Pragma("unroll") for (int m = 0; m < 4; ++m) _Pragma("unroll") for (int n = 0; n < 2; ++n) _Pragma("unroll") for (int k = 0; k < 2; ++k) \
        acc[ai][bj][m][n] = __builtin_amdgcn_mfma_f32_16x16x32_bf16(Bt[n][k], At[m][k], acc[ai][bj][m][n], 0, 0, 0); __builtin_amdgcn_s_setprio(0); } while (0)
#define PG8_WAIT_V(n) asm volatile("s_waitcnt vmcnt(" #n ")" ::: "memory")
#define PG8_WAIT_L(n) asm volatile("s_waitcnt lgkmcnt(" #n ")" ::: "memory")
#define PG8_BAR __builtin_amdgcn_s_barrier()
#define PG8_SCHED __builtin_amdgcn_sched_barrier(0)
    Unit cur, nxt; int ui = 0;
    if (!S.next(0, cur)) return;
    f32x4 acc[2][2][4][2];
#pragma unroll
    for (int a = 0; a < 2; ++a)
#pragma unroll
        for (int b = 0; b < 2; ++b)
#pragma unroll
            for (int m = 0; m < 4; ++m)
#pragma unroll
                for (int n = 0; n < 2; ++n) acc[a][b][m][n] = (f32x4){0.f, 0.f, 0.f, 0.f};
    bf16x8 At[4][2], B0[2][2], B1[2][2];
    const char* cA = (const char*)g.A + (size_t)cur.pm * tstepA; const char* cB = (const char*)g.Bt + (size_t)cur.pn * tstepB;
    PG8_STAGE(PG8_SB(0, 0), cB, voffB); PG8_STAGE(PG8_SB(0, 1), cB + hstepB, voffB); PG8_STAGE(PG8_SA(0, 0), cA, voffA); PG8_STAGE(PG8_SA(0, 1), cA + hstepA, voffA);
    if (wr == 1) PG8_BAR;
    PG8_WAIT_V(2); PG8_BAR;
    PG8_STAGE(PG8_SB(1, 0), cB + kstep, voffB); PG8_STAGE(PG8_SA(1, 0), cA + kstep, voffA); PG8_STAGE(PG8_SB(1, 1), cB + hstepB + kstep, voffB);
    PG8_WAIT_V(6); PG8_BAR;
    for (;;) {
        const bool has_next = S.next(ui + 1, nxt);
        const char* nA = has_next ? (const char*)g.A + (size_t)nxt.pm * tstepA : cA; const char* nB = has_next ? (const char*)g.Bt + (size_t)nxt.pn * tstepB : cB;
        for (int t = 0; t < nt; t += 2) {
            const bool last = (t == nt - 2);
            const char* a1 = cA + (size_t)(t + 1) * kstep;
            const char* a2 = last ? nA : cA + (size_t)(t + 2) * kstep; const char* b2 = last ? nB : cB + (size_t)(t + 2) * kstep;
            const char* a3 = a2 + kstep; const char* b3 = b2 + kstep;
            PG8_LDB(B0, 0, 0); PG8_LDB(B1, 0, 1); PG8_SCHED; PG8_LDA(At, 0, 0); PG8_STAGE(PG8_SA(1, 1), a1 + hstepA, voffA);
            PG8_WAIT_V(8); PG8_WAIT_L(0); PG8_BAR; PG8_MMA(0, 0, At, B0); PG8_MMA(0, 1, At, B1); PG8_BAR; PG8_SCHED;
            PG8_LDA(At, 0, 1); PG8_STAGE(PG8_SB(0, 0), b2, voffB); PG8_STAGE(PG8_SB(0, 1), b2 + hstepB, voffB); PG8_STAGE(PG8_SA(0, 0), a2, voffA);
            PG8_WAIT_V(8); PG8_WAIT_L(0); PG8_BAR; PG8_MMA(1, 0, At, B0); PG8_MMA(1, 1, At, B1); PG8_BAR; PG8_SCHED;
            PG8_LDB(B0, 1, 0); PG8_LDB(B1, 1, 1); PG8_SCHED; PG8_LDA(At, 1, 0); PG8_STAGE(PG8_SA(0, 1), a2 + hstepA, voffA);
            PG8_WAIT_V(8); PG8_WAIT_L(0); PG8_BAR; PG8_MMA(0, 0, At, B0); PG8_MMA(0, 1, At, B1); PG8_BAR; PG8_SCHED;
            PG8_LDA(At, 1, 1); PG8_STAGE(PG8_SB(1, 0), b3, voffB); PG8_STAGE(PG8_SB(1, 1), b3 + hstepB, voffB); PG8_STAGE(PG8_SA(1, 0), a3, voffA);
            PG8_WAIT_V(8); PG8_WAIT_L(0); PG8_BAR; PG8_MMA(1, 0, At, B0); PG8_MMA(1, 1, At, B1); PG8_BAR; PG8_SCHED;
        }
        if (wr == 0) PG8_BAR;
        { int fr_ = fr, fq_ = fq; asm volatile("" : "+v"(fr_), "+v"(fq_));
          E(acc, cur, wr, wc, fr_, fq_); }
        if (!has_next) break;
#pragma unroll
        for (int a = 0; a < 2; ++a)
#pragma unroll
            for (int b = 0; b < 2; ++b)
#pragma unroll
                for (int m = 0; m < 4; ++m)
#pragma unroll
                    for (int n = 0; n < 2; ++n) acc[a][b][m][n] = (f32x4){0.f, 0.f, 0.f, 0.f};
        cur = nxt; cA = nA; cB = nB; ++ui;
        if (wr == 1) PG8_BAR;
    }
    PG8_WAIT_V(0);
    PG8_BAR;
#undef PG8_SA
#undef PG8_SB
#undef PG8_STAGE
#undef PG8_LDA
#undef PG8_LDB
#undef PG8_MMA
#undef PG8_WAIT_V
#undef PG8_WAIT_L
#undef PG8_BAR
#undef PG8_SCHED
}

__device__ __forceinline__ float row_rscale(const float* SSP, int row) {
    const f32x4 p = *(const f32x4*)(SSP + (size_t)row * 4);
    return rsqrtf(((p[0] + p[1]) + (p[2] + p[3])) * (1.f / 1024.f) + 1e-6f);
}
__device__ __forceinline__ void row_scales8(const float* SSP, int row0, int key, LAS float* rsc  , LAS int* rtag  , int wv, int fr, int fq, float (&rsv)[2][4]) {
    const int tag = __builtin_amdgcn_readfirstlane(rtag[wv]);
    LAS float* tab = rsc + (wv * 16 + fr) * 8;
    if (tag == key) {
        const f32x4 a = *(const LAS f32x4*)tab, b = *(const LAS f32x4*)(tab + 4);
#pragma unroll
        for (int m = 0; m < 4; ++m) { rsv[0][m] = a[m]; rsv[1][m] = b[m]; }
    } else {
#pragma unroll
        for (int ai = 0; ai < 2; ++ai)
#pragma unroll
            for (int m = 0; m < 4; ++m) rsv[ai][m] = row_rscale(SSP, row0 + ai * HALF + m * 16);
        if (fq == 0) { *(LAS f32x4*)tab = (f32x4){rsv[0][0], rsv[0][1], rsv[0][2], rsv[0][3]}; *(LAS f32x4*)(tab + 4) = (f32x4){rsv[1][0], rsv[1][1], rsv[1][2], rsv[1][3]}; if (fr == 0) rtag[wv] = key; }
    }
}
typedef float f32x2 __attribute__((ext_vector_type(2)));
__device__ __forceinline__ f32x2 swiglu_pk(f32x2 g, f32x2 u, float c1, float rs2) {
    const f32x2 t = g * c1; f32x2 e; e.x = __builtin_amdgcn_exp2f(t.x); e.y = __builtin_amdgcn_exp2f(t.y);
    const f32x2 d = e + 1.0f; f32x2 sg; sg.x = __builtin_amdgcn_rcpf(d.x); sg.y = __builtin_amdgcn_rcpf(d.y);
    return (g * u) * (sg * rs2);
}
__device__ __forceinline__ f32x2 glu_pk(f32x2 a, f32x2 b, float c1, float rs) {
    const f32x2 t = b * c1; f32x2 e; e.x = __builtin_amdgcn_exp2f(t.x); e.y = __builtin_amdgcn_exp2f(t.y);
    const f32x2 d = e + 1.0f; f32x2 sg; sg.x = __builtin_amdgcn_rcpf(d.x); sg.y = __builtin_amdgcn_rcpf(d.y);
    return a * (sg * rs);
}
struct EpiSwiglu {
    static constexpr bool PERM = true;
    bf16_t* U; const float* SSP; LAS float* rsc; LAS int* rtag; int key0;
    __device__ __forceinline__ void operator()(const f32x4 (&acc)[2][2][4][2], const Unit& u, int wr, int wc, int fr, int fq) const {
        const int row0 = u.pm * BM + wr * 64 + fr, col0 = u.pn * 128 + wc * 32 + 8 * fq;
        float rsv[2][4];
        row_scales8(SSP, row0, key0 + u.pm, rsc, rtag, wr * 4 + wc, fr, fq, rsv);
#pragma unroll
        for (int ai = 0; ai < 2; ++ai) {
#pragma unroll
            for (int m = 0; m < 4; ++m) {
                const int row = row0 + ai * HALF + m * 16;
                const float rs = rsv[ai][m];
                bf16_t* rowp = U + (size_t)row * FF + col0;
                const float c1 = -rs * LOG2E, rs2 = rs * rs;
                const f32x4 g0 = acc[ai][0][m][0], g1 = acc[ai][0][m][1], u0 = acc[ai][1][m][0], u1 = acc[ai][1][m][1];
                const f32x2 o0 = swiglu_pk((f32x2){g0[0], g0[1]}, (f32x2){u0[0], u0[1]}, c1, rs2), o1 = swiglu_pk((f32x2){g0[2], g0[3]}, (f32x2){u0[2], u0[3]}, c1, rs2);
                const f32x2 o2 = swiglu_pk((f32x2){g1[0], g1[1]}, (f32x2){u1[0], u1[1]}, c1, rs2), o3 = swiglu_pk((f32x2){g1[2], g1[3]}, (f32x2){u1[2], u1[3]}, c1, rs2);
                u32x4 w; w.x = pk2(o0.x, o0.y); w.y = pk2(o1.x, o1.y); w.z = pk2(o2.x, o2.y); w.w = pk2(o3.x, o3.y);
                *(u32x4*)rowp = w;
            }
        }
    }
};
struct EpiResid {
    static constexpr bool PERM = true;
    bf16_t* XB; float* SSP; float scale; LAS float* red;
    __device__ __forceinline__ void operator()(const f32x4 (&acc)[2][2][4][2], const Unit& u, int wr, int wc, int fr, int fq) const {
        const int row0 = u.pm * BM + wr * 64 + fr, col0 = u.pn * BM + wc * 32 + 8 * fq;
#pragma unroll
        for (int ai = 0; ai < 2; ++ai) {
            u32x4 xin[4][2];
#pragma unroll
            for (int m = 0; m < 4; ++m) { const size_t ro = (size_t)(row0 + ai * HALF + m * 16) * D + col0; xin[m][0] = *(const u32x4*)(XB + ro); xin[m][1] = *(const u32x4*)(XB + ro + HALF); }
#pragma unroll
            for (int m = 0; m < 4; ++m) {
                const int row = row0 + ai * HALF + m * 16;
                const size_t ro = (size_t)row * D + col0;
                float ss = 0.f;
#pragma unroll
                for (int bj = 0; bj < 2; ++bj) {
                    const u32x4 xi = xin[m][bj];
                    const f32x4 a0 = acc[ai][bj][m][0] * scale, a1 = acc[ai][bj][m][1] * scale;
                    u32x4 w;
                    w.x = pk2(bflo(xi.x) + a0[0], bfhi(xi.x) + a0[1]); w.y = pk2(bflo(xi.y) + a0[2], bfhi(xi.y) + a0[3]);
                    w.z = pk2(bflo(xi.z) + a1[0], bfhi(xi.z) + a1[1]); w.w = pk2(bflo(xi.w) + a1[2], bfhi(xi.w) + a1[3]);
                    *(u32x4*)(XB + ro + bj * HALF) = w;
                    const float r0 = bflo(w.x), r1 = bfhi(w.x), r2 = bflo(w.y), r3 = bfhi(w.y), r4 = bflo(w.z), r5 = bfhi(w.z), r6 = bflo(w.w), r7 = bfhi(w.w);
                    ss += ((r0 * r0 + r1 * r1) + (r2 * r2 + r3 * r3)) + ((r4 * r4 + r5 * r5) + (r6 * r6 + r7 * r7));
                }
                { const int ln_ = fq * 16 + fr; ss += shflx(ss, 16, ln_); ss += shflx(ss, 32, ln_); }
                if (fq == 0) red[((wr * 4 + wc) * 8 + ai * 4 + m) * 16 + fr] = ss;
            }
        }
        asm volatile("s_waitcnt lgkmcnt(0)" ::: "memory"); __builtin_amdgcn_s_barrier(); asm volatile("" ::: "memory");
        if (wc == 0) {
            const int ln_ = fq * 16 + fr;
#pragma unroll
            for (int e = 0; e < 2; ++e) {
                const int idx = ln_ + 64 * e, k = idx >> 4, f = idx & 15;
                const float sum = (red[((wr * 4 + 0) * 8 + k) * 16 + f] + red[((wr * 4 + 1) * 8 + k) * 16 + f]) + (red[((wr * 4 + 2) * 8 + k) * 16 + f] + red[((wr * 4 + 3) * 8 + k) * 16 + f]);
                SSP[(size_t)(u.pm * BM + (k >> 2) * HALF + wr * 64 + (k & 3) * 16 + f) * 4 + u.pn] = sum;
            }
        }
    }
};
template <int TILE0> struct EpiWinT {
    static constexpr bool PERM = true;
    unsigned char* ws; LAS float* rsc; LAS int* rtag; int key0;
    __device__ __forceinline__ void operator()(const f32x4 (&acc)[2][2][4][2], const Unit& u, int wr, int wc, int fr, int fq) const {
        const int row0 = u.pm * BM + wr * 64 + fr, cl = wc * 32 + 8 * fq;
        const int pn = TILE0 + u.pn;
        float rsv[2][4];
        row_scales8((const float*)(ws + WS_SSP), row0, key0 + u.pm, rsc, rtag, wr * 4 + wc, fr, fq, rsv);
#pragma unroll
        for (int ai = 0; ai < 2; ++ai) {
#pragma unroll
            for (int m = 0; m < 4; ++m) {
                const int row = row0 + ai * HALF + m * 16;
                const float rs = rsv[ai][m];
                if (pn >= 4 && pn <= 7) {
                    const float c1 = -rs * LOG2E;
                    const f32x4 a0 = acc[ai][0][m][0], a1 = acc[ai][0][m][1], b0 = acc[ai][1][m][0], b1 = acc[ai][1][m][1];
                    const f32x2 o0 = glu_pk((f32x2){a0[0], a0[1]}, (f32x2){b0[0], b0[1]}, c1, rs), o1 = glu_pk((f32x2){a0[2], a0[3]}, (f32x2){b0[2], b0[3]}, c1, rs);
                    const f32x2 o2 = glu_pk((f32x2){a1[0], a1[1]}, (f32x2){b1[0], b1[1]}, c1, rs), o3 = glu_pk((f32x2){a1[2], a1[3]}, (f32x2){b1[2], b1[3]}, c1, rs);
                    u32x4 w; w.x = pk2(o0.x, o0.y); w.y = pk2(o1.x, o1.y); w.z = pk2(o2.x, o2.y); w.w = pk2(o3.x, o3.y);
                    *(u32x4*)((bf16_t*)(ws + WS_GLU) + (size_t)row * 512 + (pn - 4) * 128 + cl) = w;
                } else if (pn == 9) {
                    if (wc == 0) {
                        const f32x4 a0 = acc[ai][0][m][0] * rs, a1 = acc[ai][0][m][1] * rs;
                        float* gp = (float*)(ws + WS_G) + (size_t)row * 32 + 8 * fq;
                        *(f32x4*)gp = (f32x4){fsigmoid(a0[0]), fsigmoid(a0[1]), fsigmoid(a0[2]), fsigmoid(a0[3])};
                        *(f32x4*)(gp + 4) = (f32x4){fsigmoid(a1[0]), fsigmoid(a1[1]), fsigmoid(a1[2]), fsigmoid(a1[3])};
                    }
                } else {
#pragma unroll
                    for (int bj = 0; bj < 2; ++bj) {
                        const float rq = (pn < 2) ? rs * (0.125f * LOG2E) : rs;
                        const f32x4 v0 = acc[ai][bj][m][0] * rq, v1 = acc[ai][bj][m][1] * rq;
                        u32x4 w; w.x = pk2(v0[0], v0[1]); w.y = pk2(v0[2], v0[3]); w.z = pk2(v1[0], v1[1]); w.w = pk2(v1[2], v1[3]);
                        bf16_t* dst;
                        if (pn < 2) dst = (bf16_t*)(ws + WS_Q) + (size_t)row * 512 + pn * 256 + bj * 128 + cl;
                        else if (pn == 2) { const int b = row >> 12, tok = row & 4095, gg = cl >> 6, d0 = cl & 63;
                            dst = (bf16_t*)(ws + WS_KCMP) + ((size_t)((bj * 16 + b * 2 + gg) * 4096 + tok)) * 64 + d0; }
                        else if (pn == 3) dst = (bf16_t*)(ws + (bj ? WS_VS : WS_KS)) + (size_t)row * 128 + cl;
                        else dst = (bf16_t*)(ws + (bj ? WS_VW : WS_KW)) + (size_t)row * 128 + cl;
                        *(u32x4*)dst = w;
                    }
                }
            }
        }
    }
};
struct EpiCmp1 {
    static constexpr bool PERM = true;
    bf16_t* HID; const float* bias1;
    __device__ __forceinline__ void operator()(const f32x4 (&acc)[2][2][4][2], const Unit& u, int wr, int wc, int fr, int fq) const {
        const int row0 = u.pm * BM + wr * 64 + fr, cl = wc * 32 + 8 * fq;
        const float* bb = bias1 + u.pn * 256;
#pragma unroll
        for (int bj = 0; bj < 2; ++bj) {
            const f32x4 c0 = *(const f32x4*)(bb + bj * 128 + cl), c1 = *(const f32x4*)(bb + bj * 128 + cl + 4);
#pragma unroll
            for (int ai = 0; ai < 2; ++ai)
#pragma unroll
                for (int m = 0; m < 4; ++m) {
                    const f32x4 v0 = acc[ai][bj][m][0] + c0, v1 = acc[ai][bj][m][1] + c1;
                    u32x4 w; w.x = pk2(fsilu(v0[0]), fsilu(v0[1])); w.y = pk2(fsilu(v0[2]), fsilu(v0[3])); w.z = pk2(fsilu(v1[0]), fsilu(v1[1])); w.w = pk2(fsilu(v1[2]), fsilu(v1[3]));
                    *(u32x4*)(HID + (size_t)(row0 + ai * HALF + m * 16) * 256 + bj * 128 + cl) = w;
                }
        }
    }
};
struct EpiCmp2 {
    static constexpr bool PERM = false;
    bf16_t* KC; bf16_t* VC;
    __device__ __forceinline__ void operator()(const f32x4 (&acc)[2][2][4][2], const Unit& u, int wr, int wc, int fr, int fq) const {
        if (wc >= 2) return;
        bf16_t* dst = u.pn ? VC : KC;
        const int slab = u.pm & 15, b = slab >> 1, gg = slab & 1;
#pragma unroll
        for (int ai = 0; ai < 2; ++ai)
#pragma unroll
            for (int m = 0; m < 4; ++m) {
                const int nrow = ai * HALF + wr * 64 + m * 16 + fr;
#pragma unroll
                for (int n = 0; n < 2; ++n) {
                    f32x4 v = acc[ai][0][m][n]; if (nrow == 255) v = (f32x4){0.f, 0.f, 0.f, 0.f};
                    u32x2 w; w.x = pk2(v[0], v[1]); w.y = pk2(v[2], v[3]);
                    *(u32x2*)(dst + (size_t)(b * 256 + nrow) * 128 + gg * 64 + wc * 32 + 16 * n + 4 * fq) = w;
                }
            }
    }
};
}

struct Args { const float* in[23]; float* out; unsigned char* ws; int ph_lo, ph_hi; };

__device__ __forceinline__ void transpose_tile(const float* colp  , int ld, int K, bf16_t* dst, int n0, int k0, const float* gk, LAS unsigned char* lds, int tid) {
    const int c4 = tid & 31, kql = tid >> 5;
    f32x4 rr[4][4];
#pragma unroll
    for (int step = 0; step < 4; ++step) {
        const int kk = k0 + 4 * (step * 16 + kql);
#pragma unroll
        for (int i = 0; i < 4; ++i) rr[step][i] = colp ? __builtin_nontemporal_load((const f32x4*)(colp + (size_t)(kk + i) * ld)) : (f32x4){0.f, 0.f, 0.f, 0.f};
    }
#pragma unroll
    for (int step = 0; step < 4; ++step) {
        const int kq = step * 16 + kql, kk = k0 + 4 * kq;
        f32x4 r0 = rr[step][0], r1 = rr[step][1], r2 = rr[step][2], r3 = rr[step][3];
        if (gk) { const f32x4 gg = *(const f32x4*)(gk + kk); r0 *= gg[0]; r1 *= gg[1]; r2 *= gg[2]; r3 *= gg[3]; }
        const int phys = kq ^ (c4 & 15);
#pragma unroll
        for (int e = 0; e < 4; ++e) { u32x2 w; w.x = pk2(r0[e], r1[e]); w.y = pk2(r2[e], r3[e]); *(LAS u32x2*)(lds + (4 * c4 + e) * 512 + phys * 8) = w; }
    }
    __syncthreads();
#pragma unroll
    for (int it = 0; it < 8; ++it) {
        const int id = it * 512 + tid, row = id >> 5, q = id & 31, sw = (row >> 2) & 15;
        u32x4 v = *(const LAS u32x4*)(lds + row * 512 + (q ^ (sw >> 1)) * 16);
        if (sw & 1) v = (u32x4){v.z, v.w, v.x, v.y};
        *(u32x4*)(dst + (size_t)(n0 + row) * K + k0 + 8 * q) = v;
    }
    __syncthreads();
}

__device__ __forceinline__ void p0_phase(const Args& a, unsigned char* ws, LAS unsigned char* lds, const int tid, const int bid) {
    const int lane = tid & 63, wave = tid >> 6;
    const int gw = bid * 8 + wave, NGW = gridDim.x * 8;
    constexpr int JA = 176, JB = 88, JC = 80, JD = 32, JG = 32, JH = 4, JPL = 2 * (JA + JB) + JC + JD + JG + JH;
    for (int it = bid; it < NL * JPL; it += gridDim.x) {
        const int l = it / JPL; int r = it % JPL;
        bf16_t* wl = (bf16_t*)(ws + WS_W) + (size_t)l * W_LAYER;
        const int c4 = tid & 31;
        const float* colp = nullptr; int ld = 0, K = 0, n0 = 0, k0 = 0; bf16_t* dst = nullptr; const float* gk = nullptr;
        if (r < JA || (r >= JA + JB + JC + JD && r < JA + JB + JC + JD + JA)) {
            const bool second = r >= JA; if (second) r -= JA + JB + JC + JD;
            const int kb = r / 44, nb = r % 44; K = 1024; k0 = kb * 256; n0 = nb * 128; ld = FF;
            const int np = n0 + 4 * c4, tile = np >> 8, within = np & 255;
            const float* src = (within < 128) ? a.in[second ? 19 : 2] : a.in[second ? 20 : 3];
            colp = src + (size_t)l * D * FF + tile * 128 + (within & 127);
            dst = wl + (second ? OFF_SW2 : OFF_SW1); gk = a.in[second ? 18 : 1] + l * D;
        } else if ((r >= JA && r < JA + JB) || (r >= JA + JB + JC + JD + JA && r < JA + JB + JC + JD + JA + JB)) {
            const bool second = r >= JA + JB; r -= second ? (JA + JB + JC + JD + JA) : JA;
            const int kb = r / 8, nb = r % 8; K = FF; k0 = kb * 256; n0 = nb * 128; ld = D;
            colp = a.in[second ? 21 : 4] + (size_t)l * FF * D + n0 + 4 * c4;
            dst = wl + (second ? OFF_DN2 : OFF_DN1);
        } else if (r < JA + JB + JC) {
            r -= JA + JB;
            const int kb = r / 20, nb = r % 20; K = 1024; k0 = kb * 256; n0 = nb * 128; ld = INW;
            const int np = n0 + 4 * c4; int col;
            if (np < 1024) col = np;
            else if (np < 2048) { const int tt = (np - 1024) >> 8, within = (np - 1024) & 255; col = (within < 128) ? (1304 + 128 * tt + within) : (1816 + 128 * tt + within - 128); }
            else if (np < 2304) col = 1024 + (np - 2048);
            else { const int within = np - 2304; col = within < 24 ? 1280 + within : -1; }
            colp = col >= 0 ? a.in[6] + (size_t)l * D * INW + col : nullptr;
            dst = wl + OFF_WIN; gk = a.in[5] + l * D;
        } else if (r < JA + JB + JC + JD) {
            r -= JA + JB + JC;
            const int kb = r / 8, nb = r % 8; K = 1024; k0 = kb * 256; n0 = nb * 128; ld = D;
            colp = a.in[17] + (size_t)l * D * D + n0 + 4 * c4;
            dst = wl + OFF_WOUT;
        } else if (r < 2 * (JA + JB) + JC + JD + JG) {
            r -= 2 * (JA + JB) + JC + JD;
            const int kb = r / 4, nb = r % 4; K = 2048; k0 = kb * 256; n0 = nb * 128; ld = 256;
            const int np = n0 + 4 * c4, kv = np >> 8;
            colp = a.in[kv ? 11 : 8] + (size_t)l * 2048 * 256 + (np & 255);
            dst = (bf16_t*)(ws + WS_CW1) + (size_t)l * 512 * 2048;
        } else {
            r -= 2 * (JA + JB) + JC + JD + JG;
            const int nb = r; K = 256; k0 = 0; n0 = nb * 128; ld = 64;
            const int np = n0 + 4 * c4, kv = np >> 8, within = np & 255;
            colp = within < 64 ? a.in[kv ? 12 : 9] + (size_t)l * 256 * 64 + within : nullptr;
            dst = (bf16_t*)(ws + WS_CW2) + (size_t)l * 512 * 256;
        }
        transpose_tile(colp, ld, K, dst, n0, k0, gk, lds, tid);
    }
    {
        bf16_t* XB = (bf16_t*)(ws + WS_H); float* SSP = (float*)(ws + WS_SSP);
        for (int m0 = gw; m0 < T; m0 += 2 * NGW) {
            f32x4 v[2][4]; float ssum[2] = {0.f, 0.f};
#pragma unroll
            for (int e = 0; e < 2; ++e) { const int mm = (m0 + e * NGW < T) ? m0 + e * NGW : m0; const float* xr = a.in[0] + (size_t)mm * D + 4 * lane;
#pragma unroll
                for (int j = 0; j < 4; ++j) v[e][j] = __builtin_nontemporal_load((const f32x4*)(xr + 256 * j)); }
#pragma unroll
            for (int e = 0; e < 2; ++e) { const int mm = (m0 + e * NGW < T) ? m0 + e * NGW : m0; bf16_t* o = XB + (size_t)mm * D + 4 * lane;
#pragma unroll
                for (int j = 0; j < 4; ++j) { u32x2 w; w.x = pk2(v[e][j][0], v[e][j][1]); w.y = pk2(v[e][j][2], v[e][j][3]); *(u32x2*)(o + 256 * j) = w;
                    const float r0 = bflo(w.x), r1 = bfhi(w.x), r2 = bflo(w.y), r3 = bfhi(w.y);
                    ssum[e] += (r0 * r0 + r1 * r1) + (r2 * r2 + r3 * r3); } }
#pragma unroll
            for (int o_ = 1; o_ < 64; o_ <<= 1) { ssum[0] += shflx(ssum[0], o_, lane); ssum[1] += shflx(ssum[1], o_, lane); }
#pragma unroll
            for (int e = 0; e < 2; ++e) { const int mm = (m0 + e * NGW < T) ? m0 + e * NGW : m0; if (lane < 4) SSP[(size_t)mm * 4 + lane] = lane == 0 ? ssum[e] : 0.f; }
        }
    }
    {
        float* PART = (float*)(ws + WS_BPART);
        for (int task = gw; task < NL * 2 * 4 * 64; task += NGW) {
            const int kc = task & 63, cg_ = (task >> 6) & 3, kv = (task >> 8) & 1, l = task >> 9;
            const int col = cg_ * 64 + lane;
            const float* pos = a.in[kv ? 10 : 7] + (size_t)l * 2048 + kc * 32;
            const float* w1 = a.in[kv ? 11 : 8] + (size_t)l * 2048 * 256 + (size_t)kc * 32 * 256 + col;
            float s0 = 0.f, s1 = 0.f, s2 = 0.f, s3 = 0.f;
#pragma unroll
            for (int k = 0; k < 32; k += 4) { s0 += pos[k] * w1[(size_t)k * 256]; s1 += pos[k + 1] * w1[(size_t)(k + 1) * 256]; s2 += pos[k + 2] * w1[(size_t)(k + 2) * 256]; s3 += pos[k + 3] * w1[(size_t)(k + 3) * 256]; }
            PART[kc * 2048 + (l * 2 + kv) * 256 + col] = (s0 + s1) + (s2 + s3);
        }
    }
}

__device__ __forceinline__ void norm_phase(const float* X, const float* gvec, bf16_t* H, const int tid, const int bid) {
    const int lane = tid & 63, wave = tid >> 6;
    const int gw = bid * 8 + wave, NGW = gridDim.x * 8;
    f32x4 gv[4];
#pragma unroll
    for (int j = 0; j < 4; ++j) gv[j] = *(const f32x4*)(gvec + 4 * lane + 256 * j);
    for (int m = gw; m < T; m += NGW) {
        const float* xr = X + (size_t)m * D + 4 * lane;
        f32x4 v[4]; float s = 0.f;
#pragma unroll
        for (int j = 0; j < 4; ++j) { v[j] = *(const f32x4*)(xr + 256 * j); s += (v[j][0] * v[j][0] + v[j][1] * v[j][1]) + (v[j][2] * v[j][2] + v[j][3] * v[j][3]); }
        const float r = rsqrtf(wave_sum(s, lane) * (1.f / D) + EPS);
        bf16_t* o = H + (size_t)m * D + 4 * lane;
#pragma unroll
        for (int j = 0; j < 4; ++j) { u32x2 w; w.x = pk2(v[j][0] * r * gv[j][0], v[j][1] * r * gv[j][1]); w.y = pk2(v[j][2] * r * gv[j][2], v[j][3] * r * gv[j][3]); *(u32x2*)(o + 256 * j) = w; }
    }
}
__device__ __forceinline__ void final_norm_phase(const bf16_t* XB, float* OUT, const float* gvec, const float* SSP, const int tid, const int bid) {
    const int lane = tid & 63, wave = tid >> 6;
    const int gw = bid * 8 + wave, NGW = gridDim.x * 8;
    f32x4 gv[4];
#pragma unroll
    for (int j = 0; j < 4; ++j) gv[j] = *(const f32x4*)(gvec + 4 * lane + 256 * j);
    for (int m0 = gw; m0 < T; m0 += 2 * NGW) {
        u32x2 w[2][4]; float r[2];
#pragma unroll
        for (int e = 0; e < 2; ++e) { const int m = m0 + e * NGW;
            if (m < T) { const bf16_t* xr = XB + (size_t)m * D + 4 * lane;
#pragma unroll
                for (int j = 0; j < 4; ++j) w[e][j] = __builtin_nontemporal_load((const u32x2*)(xr + 256 * j));
                r[e] = pg8::row_rscale(SSP, m); } }
#pragma unroll
        for (int e = 0; e < 2; ++e) { const int m = m0 + e * NGW;
            if (m < T) { float* o = OUT + (size_t)m * D + 4 * lane;
#pragma unroll
                for (int j = 0; j < 4; ++j) { const f32x4 v = {bflo(w[e][j].x), bfhi(w[e][j].x), bflo(w[e][j].y), bfhi(w[e][j].y)};
                    __builtin_nontemporal_store(v * r[e] * gv[j], (f32x4*)(o + 256 * j)); } } }
    }
}

__device__ __forceinline__ void conv_phase(const Args& a, unsigned char* ws, int l, LAS unsigned char* lds, const int tid, const int bid) {
    const int lane_outer = tid & 63, wave = tid >> 6;
    const int nskip = gridDim.x > 64 ? 64 : 0;
    if (bid < nskip) return;
    LAS float* wp = (LAS float*)lds;
    LAS unsigned char* rows = lds + 31 * 512 * 4;
    const float* cw = a.in[13] + (size_t)l * 31 * 512;
    {
        float wv[31];
#pragma unroll
        for (int j = 0; j < 31; ++j) wv[j] = cw[j * 512 + tid];
#pragma unroll
        for (int j = 0; j < 31; ++j) wp[j * 512 + tid] = wv[j];
    }
    const bf16_t* GLU = (const bf16_t*)(ws + WS_GLU);
    bf16_t* ATT = (bf16_t*)(ws + WS_ATT);
    const int nb = gridDim.x - nskip;
    for (int bt = bid - nskip; bt < T / 64; bt += nb) {
        const int R0 = bt * 64, tb0 = R0 & (SEQ - 1);
        __syncthreads();
        {
            int tq = tid; asm volatile("" : "+v"(tq));
            const int i0 = tq >> 6, ch = tq & 63;
            const bf16_t* gsrc = GLU + (size_t)(R0 - 30 + i0) * 512 + ch * 8;
            LAS unsigned char* ldst = rows + tq * 16;
            u32x4 v[12];
#pragma unroll
            for (int it = 0; it < 12; ++it) { const int i = i0 + 8 * it;
                v[it] = (i < 94 && tb0 - 30 + i >= 0) ? *(const u32x4*)(gsrc + (size_t)it * 8 * 512) : (u32x4){0u, 0u, 0u, 0u}; }
#pragma unroll
            for (int it = 0; it < 12; ++it) { if (i0 + 8 * it < 94) *(LAS u32x4*)(ldst + it * 8192) = v[it]; }
        }
        __syncthreads();
        int lane = lane_outer; asm volatile("" : "+v"(lane));
        const int cA = 4 * lane, cB = 256 + 4 * lane;
        const int row0 = R0 + 8 * wave;
        const LAS unsigned char* myrows = rows + (8 * wave) * 1024 + 8 * lane;
        f32x4 accA[8], accB[8];
#pragma unroll
        for (int tt = 0; tt < 8; ++tt) { accA[tt] = (f32x4){0.f, 0.f, 0.f, 0.f}; accB[tt] = (f32x4){0.f, 0.f, 0.f, 0.f}; }
        f32x4 FA[8], FB[8];
#pragma unroll
        for (int i = 0; i < 8; ++i) { const u32x2 ra = *(const LAS u32x2*)(myrows + i * 1024), rb = *(const LAS u32x2*)(myrows + i * 1024 + 512);
            FA[i] = (f32x4){bflo(ra.x), bfhi(ra.x), bflo(ra.y), bfhi(ra.y)}; FB[i] = (f32x4){bflo(rb.x), bfhi(rb.x), bflo(rb.y), bfhi(rb.y)}; }
#pragma unroll 1
        for (int jb = 0; jb < 32; jb += 8)
#pragma unroll
        for (int jj = 0; jj < 8; ++jj) {
            const int j = jb + jj;
            if (j >= 31) break;
            const LAS float* wr_ = wp + j * 512;
            const f32x4 wa = *(const LAS f32x4*)(wr_ + cA), wb = *(const LAS f32x4*)(wr_ + cB);
            u32x2 ra = {0u, 0u}, rb = {0u, 0u};
            if (j + 8 < 38) { ra = *(const LAS u32x2*)(myrows + (j + 8) * 1024); rb = *(const LAS u32x2*)(myrows + (j + 8) * 1024 + 512); }
#pragma unroll
            for (int tt = 0; tt < 8; ++tt) { accA[tt] += wa * FA[(jj + tt) & 7]; accB[tt] += wb * FB[(jj + tt) & 7]; }
            if (j + 8 < 38) {
                FA[jj & 7] = (f32x4){bflo(ra.x), bfhi(ra.x), bflo(ra.y), bfhi(ra.y)}; FB[jj & 7] = (f32x4){bflo(rb.x), bfhi(rb.x), bflo(rb.y), bfhi(rb.y)};
            }
            __builtin_amdgcn_sched_barrier(0);
        }
        const f32x4 biasA = *(const f32x4*)(a.in[14] + l * 512 + cA), biasB = *(const f32x4*)(a.in[14] + l * 512 + cB);
        const f32x4 lgA = *(const f32x4*)(a.in[15] + l * 512 + cA), lgB = *(const f32x4*)(a.in[15] + l * 512 + cB);
        const f32x4 lbA = *(const f32x4*)(a.in[16] + l * 512 + cA), lbB = *(const f32x4*)(a.in[16] + l * 512 + cB);
#pragma unroll
        for (int tt = 0; tt < 8; ++tt) {
            const f32x4 ya = accA[tt] + biasA, yb = accB[tt] + biasB;
            const float mu = wave_sum((ya[0] + ya[1]) + (ya[2] + ya[3]) + (yb[0] + yb[1]) + (yb[2] + yb[3]), lane) * (1.f / 512);
            const f32x4 da = ya - mu, db = yb - mu;
            const float var = wave_sum((da[0] * da[0] + da[1] * da[1]) + (da[2] * da[2] + da[3] * da[3]) + (db[0] * db[0] + db[1] * db[1]) + (db[2] * db[2] + db[3] * db[3]), lane) * (1.f / 512);
            const float rs = rsqrtf(var + EPS);
            const f32x4 za = da * rs * lgA + lbA, zb = db * rs * lgB + lbB;
            bf16_t* op = ATT + (size_t)(row0 + tt) * 1024 + 512;
            u32x2 w; w.x = pk2(fsilu(za[0]), fsilu(za[1])); w.y = pk2(fsilu(za[2]), fsilu(za[3])); *(u32x2*)(op + cA) = w;
            w.x = pk2(fsilu(zb[0]), fsilu(zb[1])); w.y = pk2(fsilu(zb[2]), fsilu(zb[3])); *(u32x2*)(op + cB) = w;
        }
    }
    __syncthreads();
}

constexpr int KPITCH = 72, VPITCH = 96;
constexpr int A_KBUF = 0, A_VBUF = 2 * 64 * KPITCH * 2;
constexpr int A_IMPA = A_VBUF + 2 * 64 * VPITCH * 2;
constexpr int IMPP = 65;
constexpr int A_IMPB = A_IMPA + 64 * IMPP * 4;
constexpr int A_SEL = A_IMPB + 64 * IMPP * 4;
constexpr int A_UNI = A_SEL + 512;
constexpr int A_OUT = A_UNI + 16;
constexpr int A_END = A_OUT + 32 * 512 * 4;
static_assert(A_END <= LDS_BYTES - 64, "attention LDS map");
static_assert(31 * 512 * 4 + 94 * 1024 <= LDS_BYTES - 64, "conv LDS map");

struct AttnState { float m, l; f32x16 o0, o1; };

template <int MODE  >
__device__ __forceinline__ void attn_pass(LAS unsigned char* lds, const bf16_t* Kg, const bf16_t* Vg  ,
                                          unsigned long long blockmask, const bf16x8 (&qf)[4], AttnState& st, int t, float slope2, unsigned long long selmask, int w, int lane_in, int tid_in, int cblk) {
    int lane = lane_in, tid = tid_in;
    asm volatile("" : "+v"(lane), "+v"(tid));
    constexpr bool NEEDV = (MODE != 3);
    constexpr bool CMPM = (MODE == 0 || MODE == 3);
    const int col = lane & 31, h = lane >> 5;
    const int skey = tid >> 3, schunk = tid & 7;
    unsigned long long rem = blockmask;
    if (!rem) return;
    int j = 63 - __builtin_clzll(rem); rem &= ~(1ull << j);
    u32x4 kreg, vreg;
    kreg = *(const u32x4*)(Kg + (size_t)(64 * j + skey) * 128 + schunk * 8);
    if (NEEDV) vreg = *(const u32x4*)(Vg + (size_t)(64 * j + skey) * 128 + schunk * 8);
    int cur = 0;
    {
        LAS bf16_t* kb = (LAS bf16_t*)(lds + A_KBUF) + cur * 64 * KPITCH;
        *(LAS u32x4*)(kb + skey * KPITCH + schunk * 8) = kreg;
        if (NEEDV) { LAS bf16_t* vb = (LAS bf16_t*)(lds + A_VBUF) + cur * 64 * VPITCH;
            *(LAS u32x4*)(vb + skey * VPITCH + schunk * 8) = vreg; }
    }
    __syncthreads();
    for (;;) {
        const bool has_next = rem != 0ull; int jn = 0;
        if (has_next) { jn = 63 - __builtin_clzll(rem); rem &= ~(1ull << jn);
            kreg = *(const u32x4*)(Kg + (size_t)(64 * jn + skey) * 128 + schunk * 8);
            if (NEEDV) vreg = *(const u32x4*)(Vg + (size_t)(64 * jn + skey) * 128 + schunk * 8); }
        const bool selbit = (MODE == 1) ? (((selmask >> j) & 1ull) != 0ull) : true;
        bool active = true;
        if (MODE == 1) active = __builtin_amdgcn_ballot_w64(selbit) != 0ull;
        if (active) {
            const LAS bf16_t* kb = (const LAS bf16_t*)(lds + A_KBUF) + cur * 64 * KPITCH;
            constexpr int STEP = CMPM ? 16 : 1;
            const int Bint = CMPM ? (1024 * j + 31 - t + 64 * h) : (64 * j - t + 4 * h);
            const float sl = slope2 * (float)STEP;
            const float mref = st.m; const bool fresh = !(mref > -1e28f);
            const float mest = fresh ? 0.f : mref;
            const float basef = selbit ? (slope2 * (float)Bint - mest) : -1e30f;
            int ptype;
            if (MODE == 1) ptype = (j == cblk) ? 1 : 0;
            else if (MODE == 2) ptype = (j == cblk) ? 1 : ((j == cblk - 8) ? 2 : 0);
            else ptype = (64 * j + 63 <= 4 * cblk - 2) ? 0 : 1;
            f32x16 s0, s1;
            { const float sl2 = sl + sl, sl3 = sl2 + sl;
#pragma unroll
              for (int g8 = 0; g8 < 4; ++g8) {
                  const float b0 = __builtin_fmaf(sl, (float)(8 * g8), basef), b1 = __builtin_fmaf(sl, (float)(8 * g8 + 32), basef);
                  s0[4 * g8] = b0; s0[4 * g8 + 1] = b0 + sl; s0[4 * g8 + 2] = b0 + sl2; s0[4 * g8 + 3] = b0 + sl3;
                  s1[4 * g8] = b1; s1[4 * g8 + 1] = b1 + sl; s1[4 * g8 + 2] = b1 + sl2; s1[4 * g8 + 3] = b1 + sl3;
              } }
            if (ptype == 1) {
                const float thr = 0.5f * slope2 - mest;
#pragma unroll
                for (int i = 0; i < 16; ++i) { s0[i] = (s0[i] < thr) ? s0[i] : -1e30f; s1[i] = (s1[i] < thr) ? s1[i] : -1e30f; }
            } else if (ptype == 2) {
                const float thr = -511.5f * slope2 - mest;
#pragma unroll
                for (int i = 0; i < 16; ++i) { s0[i] = (s0[i] > thr) ? s0[i] : -1e30f; s1[i] = (s1[i] > thr) ? s1[i] : -1e30f; }
            }
#pragma unroll
            for (int kk = 0; kk < 4; ++kk) {
                const bf16x8 k0 = *(const LAS bf16x8*)(kb + col * KPITCH + kk * 16 + h * 8);
                const bf16x8 k1 = *(const LAS bf16x8*)(kb + (32 + col) * KPITCH + kk * 16 + h * 8);
                s0 = __builtin_amdgcn_mfma_f32_32x32x16_bf16(k0, qf[kk], s0, 0, 0, 0);
                s1 = __builtin_amdgcn_mfma_f32_32x32x16_bf16(k1, qf[kk], s1, 0, 0, 0);
            }
            if (MODE != 3) {
                float mx = fmaxf(s0[0], s1[0]);
#pragma unroll
                for (int i = 1; i < 16; ++i) mx = fmaxf(mx, fmaxf(s0[i], s1[i]));
                mx = fmaxf(mx, shflx(mx, 32, lane));
                float alpha = 1.f;
                if (__builtin_amdgcn_ballot_w64(fresh || mx > 0.f) != 0ull) {
                    const float moldr = fresh ? -1e29f : 0.f, mnewr = fmaxf(moldr, mx);
                    alpha = __builtin_amdgcn_exp2f(moldr - mnewr);
                    st.m = mest + mnewr;
#pragma unroll
                    for (int i = 0; i < 16; ++i) { s0[i] = __builtin_amdgcn_exp2f(s0[i] - mnewr); s1[i] = __builtin_amdgcn_exp2f(s1[i] - mnewr); }
                    st.o0 *= alpha; st.o1 *= alpha;
                } else {
#pragma unroll
                    for (int i = 0; i < 16; ++i) { s0[i] = __builtin_amdgcn_exp2f(s0[i]); s1[i] = __builtin_amdgcn_exp2f(s1[i]); }
                }
                { typedef float f32x8 __attribute__((ext_vector_type(8)));
                  const f32x16 t16 = s0 + s1;
                  const f32x8 t8 = __builtin_shufflevector(t16, t16, 0, 1, 2, 3, 4, 5, 6, 7) + __builtin_shufflevector(t16, t16, 8, 9, 10, 11, 12, 13, 14, 15);
                  const f32x4 t4 = __builtin_shufflevector(t8, t8, 0, 1, 2, 3) + __builtin_shufflevector(t8, t8, 4, 5, 6, 7);
                  float ps = (t4[0] + t4[1]) + (t4[2] + t4[3]);
                  ps += shflx(ps, 32, lane);
                  st.l = st.l * alpha + ps; }
                bf16x8 pf[4];
#pragma unroll
                for (int kk = 0; kk < 4; ++kk) {
                    u32x4 pw;
                    if (kk < 2) { pw.x = pk2(s0[8 * kk], s0[8 * kk + 1]); pw.y = pk2(s0[8 * kk + 2], s0[8 * kk + 3]); pw.z = pk2(s0[8 * kk + 4], s0[8 * kk + 5]); pw.w = pk2(s0[8 * kk + 6], s0[8 * kk + 7]); }
                    else { const int k2 = kk - 2; pw.x = pk2(s1[8 * k2], s1[8 * k2 + 1]); pw.y = pk2(s1[8 * k2 + 2], s1[8 * k2 + 3]); pw.z = pk2(s1[8 * k2 + 4], s1[8 * k2 + 5]); pw.w = pk2(s1[8 * k2 + 6], s1[8 * k2 + 7]); }
                    pf[kk] = __builtin_bit_cast(bf16x8, pw);
                }
                const LAS bf16_t* vb = (const LAS bf16_t*)(lds + A_VBUF) + cur * 64 * VPITCH + (4 * h + ((lane & 15) >> 2)) * VPITCH + ((lane >> 4) & 1) * 16 + 4 * (lane & 3);
#pragma unroll
                for (int kk = 0; kk < 4; ++kk) {
                    typedef short v4i16_t __attribute__((ext_vector_type(4)));
                    const v4i16_t a0 = __builtin_amdgcn_ds_read_tr16_b64_v4i16((LAS v4i16_t*)(vb + (16 * kk) * VPITCH));
                    const v4i16_t a1 = __builtin_amdgcn_ds_read_tr16_b64_v4i16((LAS v4i16_t*)(vb + (16 * kk + 8) * VPITCH));
                    const v4i16_t b0 = __builtin_amdgcn_ds_read_tr16_b64_v4i16((LAS v4i16_t*)(vb + (16 * kk) * VPITCH + 32));
                    const v4i16_t b1 = __builtin_amdgcn_ds_read_tr16_b64_v4i16((LAS v4i16_t*)(vb + (16 * kk + 8) * VPITCH + 32));
                    const bf16x8 va = __builtin_shufflevector(a0, a1, 0, 1, 2, 3, 4, 5, 6, 7), vb8 = __builtin_shufflevector(b0, b1, 0, 1, 2, 3, 4, 5, 6, 7);
                    st.o0 = __builtin_amdgcn_mfma_f32_32x32x16_bf16(va, pf[kk], st.o0, 0, 0, 0);
                    st.o1 = __builtin_amdgcn_mfma_f32_32x32x16_bf16(vb8, pf[kk], st.o1, 0, 0, 0);
                }
            } else {
                const float inv = st.l > 0.f ? 1.f / st.l : 0.f;
                LAS float* impA = (LAS float*)(lds + A_IMPA); LAS float* impB = (LAS float*)(lds + A_IMPB);
                const int q = 8 * w + (col & 7);
#pragma unroll
                for (int kt = 0; kt < 2; ++kt)
#pragma unroll
                    for (int gi = 0; gi < 4; ++gi) {
                        float p[4];
#pragma unroll
                        for (int e = 0; e < 4; ++e) { const int i = 4 * gi + e; const float sv = kt ? s1[i] : s0[i]; p[e] = __builtin_amdgcn_exp2f(sv) * inv; }
                        float av = (p[0] + p[1]) + (p[2] + 0.5f * p[3]), bv = 0.5f * p[3];
                        av += shflx(av, 8, lane); av += shflx(av, 16, lane);
                        bv += shflx(bv, 8, lane); bv += shflx(bv, 16, lane);
                        const int jj = 16 * j + 8 * kt + 2 * gi + h;
                        if (col < 8 && jj < 64) { impA[q * IMPP + jj] = av; if (jj + 1 < 64) impB[q * IMPP + jj + 1] = bv; }
                    }
            }
        }
        if (has_next) {
            LAS bf16_t* kb = (LAS bf16_t*)(lds + A_KBUF) + (cur ^ 1) * 64 * KPITCH;
            *(LAS u32x4*)(kb + skey * KPITCH + schunk * 8) = kreg;
            if (NEEDV) { LAS bf16_t* vb = (LAS bf16_t*)(lds + A_VBUF) + (cur ^ 1) * 64 * VPITCH;
                *(LAS u32x4*)(vb + skey * VPITCH + schunk * 8) = vreg; }
        }
        __syncthreads();
        if (!has_next) break;
        j = jn; cur ^= 1;
    }
}

__device__ __forceinline__ void attn_unit(unsigned char* ws, LAS unsigned char* lds, int b, int g, int c, const int tid) {
    const int lane = tid & 63, w = tid >> 6, col = lane & 31, h = lane >> 5, r = col >> 3, qi = col & 7;
    const int q = 8 * w + qi, t = 64 * c + q, head = g * 4 + r;
    const size_t row = (size_t)b * SEQ + t;
    const float slope2 = exp2f(-(float)(head + 1)) * LOG2E;
    const bf16_t* Qp = (const bf16_t*)(ws + WS_Q) + row * 512 + head * 64 + 8 * h;
    bf16x8 qf[4];
#pragma unroll
    for (int kk = 0; kk < 4; ++kk) qf[kk] = *(const bf16x8*)(Qp + 16 * kk);
    for (int i = tid; i < 2 * 64 * IMPP; i += 512) ((LAS float*)(lds + A_IMPA))[i] = 0.f;
    LAS float* outl = (LAS float*)(lds + A_OUT) + tid;
    const size_t boff = (size_t)b * SEQ * 128 + g * 64;
    const int nvalid = 4 * c + 3 > 255 ? 255 : 4 * c + 3;
    const int nkb = (nvalid + 63) >> 6;
    const unsigned long long cmpmask = (nkb >= 64) ? ~0ull : ((1ull << nkb) - 1ull);
    const bf16_t* KCp = (const bf16_t*)(ws + WS_KC) + (size_t)b * 256 * 128 + g * 64;
    const bf16_t* VCp = (const bf16_t*)(ws + WS_VC) + (size_t)b * 256 * 128 + g * 64;
    AttnState st; st.m = -1e29f; st.l = 0.f; st.o0 = (f32x16){}; st.o1 = (f32x16){};
    attn_pass<0>(lds, KCp, VCp, cmpmask, qf, st, t, slope2, 0ull, w, lane, tid, c);
    { const float gate0 = ((const float*)(ws + WS_G))[row * 32 + head * 3 + 0]; const float sc = st.l > 0.f ? gate0 / st.l : 0.f;
#pragma unroll
      for (int i = 0; i < 16; ++i) { outl[i * 512] = st.o0[i] * sc; outl[(16 + i) * 512] = st.o1[i] * sc; } }
    unsigned long long selmask, unionmask;
    if (c >= 16) {
        attn_pass<3>(lds, KCp, VCp, cmpmask, qf, st, t, slope2, 0ull, w, lane, tid, c);
        LAS float* impA = (LAS float*)(lds + A_IMPA); LAS float* impB = (LAS float*)(lds + A_IMPB);
        int tidk = tid; asm volatile("" : "+v"(tidk));
        for (int i = tidk; i < 64 * 64; i += 512) { const int qq = i >> 6, jj = i & 63; impA[qq * IMPP + jj] += impB[qq * IMPP + jj]; }
        __syncthreads();
        {
            const int qq = tidk >> 3, jg = tidk & 7;
            float mine[8]; int rank[8];
#pragma unroll
            for (int e = 0; e < 8; ++e) { mine[e] = impA[qq * IMPP + 8 * jg + e]; rank[e] = 0; }
            for (int jp = 1; jp <= c - 2; ++jp) {
                const float v = impA[qq * IMPP + jp];
#pragma unroll
                for (int e = 0; e < 8; ++e) { const int jm = 8 * jg + e; rank[e] += (v > mine[e] || (v == mine[e] && jp < jm)) ? 1 : 0; }
            }
            unsigned bits = 0;
#pragma unroll
            for (int e = 0; e < 8; ++e) { const int jm = 8 * jg + e; const bool cand = jm >= 1 && jm <= c - 2; const bool forced = jm == 0 || jm == c || jm == c - 1;
                if (forced || (cand && rank[e] < 13)) bits |= 1u << e; }
            ((LAS unsigned char*)(lds + A_SEL))[qq * 8 + jg] = (unsigned char)bits;
        }
        __syncthreads();
        if (w == 0) {
            const u32x2 mm = *(const LAS u32x2*)(lds + A_SEL + lane * 8);
            unsigned lo = mm.x, hi = mm.y;
#pragma unroll
            for (int o = 1; o < 64; o <<= 1) { lo |= shflxu(lo, o, lane); hi |= shflxu(hi, o, lane); }
            if (lane == 0) { *(LAS u32x2*)(lds + A_UNI) = (u32x2){lo, hi}; }
        }
        __syncthreads();
        { const u32x2 mm = *(const LAS u32x2*)(lds + A_SEL + q * 8); selmask = ((unsigned long long)mm.y << 32) | mm.x;
          const u32x2 uu = *(const LAS u32x2*)(lds + A_UNI); unionmask = ((unsigned long long)uu.y << 32) | uu.x; }
    } else {
        selmask = (1ull << (c + 1)) - 1ull; unionmask = selmask;
    }
    st.m = -1e29f; st.l = 0.f; st.o0 = (f32x16){}; st.o1 = (f32x16){};
    attn_pass<1>(lds, (const bf16_t*)(ws + WS_KS) + boff, (const bf16_t*)(ws + WS_VS) + boff, unionmask, qf, st, t, slope2, selmask, w, lane, tid, c);
    { const float gate1 = ((const float*)(ws + WS_G))[row * 32 + head * 3 + 1]; const float sc = st.l > 0.f ? gate1 / st.l : 0.f;
#pragma unroll
      for (int i = 0; i < 16; ++i) { outl[i * 512] += st.o0[i] * sc; outl[(16 + i) * 512] += st.o1[i] * sc; } }
    st.m = -1e29f; st.l = 0.f; st.o0 = (f32x16){}; st.o1 = (f32x16){};
    { const int jlo = c >= 8 ? c - 8 : 0; const unsigned long long upto = (c >= 63) ? ~0ull : ((1ull << (c + 1)) - 1ull);
      const unsigned long long winmask = upto & ~((1ull << jlo) - 1ull);
      attn_pass<2>(lds, (const bf16_t*)(ws + WS_KW) + boff, (const bf16_t*)(ws + WS_VW) + boff, winmask, qf, st, t, slope2, 0ull, w, lane, tid, c); }
    { const float gate2 = ((const float*)(ws + WS_G))[row * 32 + head * 3 + 2]; const float sc = st.l > 0.f ? gate2 / st.l : 0.f;
#pragma unroll
      for (int i = 0; i < 16; ++i) { st.o0[i] = outl[i * 512] + st.o0[i] * sc; st.o1[i] = outl[(16 + i) * 512] + st.o1[i] * sc; } }
    bf16_t* op = (bf16_t*)(ws + WS_ATT) + row * 1024 + head * 64 + 4 * h;
#pragma unroll
    for (int gi = 0; gi < 4; ++gi) {
        u32x2 w0; w0.x = pk2(st.o0[4 * gi], st.o0[4 * gi + 1]); w0.y = pk2(st.o0[4 * gi + 2], st.o0[4 * gi + 3]); *(u32x2*)(op + 8 * gi) = w0;
        u32x2 w1; w1.x = pk2(st.o1[4 * gi], st.o1[4 * gi + 1]); w1.y = pk2(st.o1[4 * gi + 2], st.o1[4 * gi + 3]); *(u32x2*)(op + 32 + 8 * gi) = w1;
    }
}

__device__ __forceinline__ void attn_phase(unsigned char* ws, LAS unsigned char* lds, const int tid, const int bid, const int l) {
    unsigned* ctr = (unsigned*)(ws + WS_CTL) + 3584 + 64 * l;
    volatile LAS int* slot = (volatile LAS int*)(lds + LDS_MISC + 48);
    if (tid == 0) slot[0] = (int)__hip_atomic_fetch_add(ctr, 1u, __ATOMIC_RELAXED, __HIP_MEMORY_SCOPE_AGENT);
    __syncthreads();
    int u = slot[0];
    while (u < 1024) {
        __syncthreads();
        if (tid == 0) slot[0] = (int)__hip_atomic_fetch_add(ctr, 1u, __ATOMIC_RELAXED, __HIP_MEMORY_SCOPE_AGENT);
        int b, g, c;
        if (u < 384) { g = 1; c = 63 - (u >> 3); b = u & 7; }
        else if (u < 768) { const int v = u - 384; g = 0; c = 63 - (v >> 3); b = v & 7; }
        else { const int v = u - 768; c = 15 - (v >> 4); g = (v >> 3) & 1; b = v & 7; }
        attn_unit(ws, lds, b, g, c, tid);
        __syncthreads();
        u = slot[0];
    }
}

#define XB_TMO      128
#define XB_XCNT(j)  (256  + 64 * (j))
#define XB_XSUB(j)  (1280 + 64 * (j))
#define XB_XGEN(j)  (2304 + 64 * (j))
#define XB_TOP      3328
#define XB_TOPGEN   3392
#define XCD_BAR_WORDS 3456
#define XB_SPIN_CAP (1u << 18)
__device__ __forceinline__ unsigned xb_ld(unsigned* p)              { return __hip_atomic_load(p, __ATOMIC_RELAXED, __HIP_MEMORY_SCOPE_AGENT); }
__device__ __forceinline__ unsigned xb_add(unsigned* p, unsigned v) { return __hip_atomic_fetch_add(p, v, __ATOMIC_RELAXED, __HIP_MEMORY_SCOPE_AGENT); }
__device__ __forceinline__ unsigned xb_xcc_id() { return (unsigned)__builtin_amdgcn_s_getreg((3 << 11) | 20) & 0xFu; }
#define XB_SPIN(cond, bar) do { unsigned _sp = 0; while (cond) { __builtin_amdgcn_s_sleep(1); \
    if ((++_sp & 255u) == 0u) { if (xb_ld(&(bar)[XB_TMO])) break; if (_sp > XB_SPIN_CAP) { atomicAdd(&(bar)[XB_TMO], 1u); break; } } } } while (0)
struct XcdBarrier { unsigned* bar; unsigned x; volatile LAS unsigned* st; };
__device__ __forceinline__ XcdBarrier xcd_barrier_post(unsigned* bar, volatile LAS unsigned* st) {
    XcdBarrier b; b.bar = bar; b.x = xb_xcc_id(); b.st = st;
    if (threadIdx.x == 0) (void)xb_add(&bar[XB_XCNT(b.x)], 1u);
    return b;
}
__device__ __forceinline__ void xcd_barrier_complete(unsigned* bar, unsigned x, unsigned& nloc, unsigned& nx) {
    const unsigned G = gridDim.x * gridDim.y * gridDim.z;
    unsigned sum, cnt, mine, sp = 0u;
    for (;;) {
        sum = 0u; cnt = 0u; mine = 0u;
#pragma unroll
        for (unsigned j = 0; j < 16; ++j) { const unsigned c = xb_ld(&bar[XB_XCNT(j)]); sum += c; cnt += (c > 0u) ? 1u : 0u; mine = (j == x) ? c : mine; }
        if (sum == G) break;
        __builtin_amdgcn_s_sleep(1);
        if ((++sp & 255u) == 0u) { if (xb_ld(&bar[XB_TMO])) break; if (sp > XB_SPIN_CAP) { atomicAdd(&bar[XB_TMO], 1u); break; } }
    }
    nloc = mine > 0u ? mine : 1u; nx = cnt > 0u ? cnt : 1u;
}
__device__ __forceinline__ void xcd_barrier(unsigned* bar_, volatile LAS unsigned* st_) {
    asm volatile("s_waitcnt vmcnt(0)" ::: "memory");
    __syncthreads();
    if (threadIdx.x == 0) {
        XcdBarrier b; b.bar = bar_; b.x = xb_xcc_id(); b.st = st_;
        unsigned* bar = b.bar;
        __builtin_amdgcn_s_waitcnt(0);
        unsigned nloc = b.st[0], nx = b.st[1];
        if (nloc == 0u) { xcd_barrier_complete(bar, b.x, nloc, nx); b.st[0] = nloc; b.st[1] = nx; }
        const unsigned old = xb_add(&bar[XB_XSUB(b.x)], 1u);
        const unsigned gen = old / nloc;
        if (old + 1u == (gen + 1u) * nloc) {
            __builtin_amdgcn_fence(__ATOMIC_RELEASE, "agent");
            asm volatile("s_waitcnt vmcnt(0)" ::: "memory");
            const unsigned og = xb_add(&bar[XB_TOP], 1u);
            const unsigned tg = og / nx;
            if (og + 1u == (tg + 1u) * nx) xb_add(&bar[XB_TOPGEN], 1u);
            else XB_SPIN(xb_ld(&bar[XB_TOPGEN]) == tg, bar);
            __builtin_amdgcn_fence(__ATOMIC_ACQUIRE, "agent");
            xb_add(&bar[XB_XGEN(b.x)], 1u);
            asm volatile("s_waitcnt vmcnt(0)" ::: "memory");
        } else {
            XB_SPIN(xb_ld(&bar[XB_XGEN(b.x)]) == gen, bar);
            __builtin_amdgcn_fence(__ATOMIC_ACQUIRE, "agent");
            asm volatile("s_waitcnt vmcnt(0)" ::: "memory");
        }
    }
    __syncthreads();
}

__global__ void __launch_bounds__(512, 2) fwd_megakernel(Args a_) {
    extern __shared__ __attribute__((aligned(16))) unsigned char lds_raw[];
    LAS unsigned char* lds = (LAS unsigned char*)lds_raw;
    cg::grid_group grid = cg::this_grid();
    const int G = gridDim.x;
        if (threadIdx.x < 8) ((LAS unsigned*)(lds + LDS_MISC))[threadIdx.x] = 0u;
    __syncthreads();
    (void)xcd_barrier_post((unsigned*)(a_.ws + WS_CTL), (volatile LAS unsigned*)(lds + LDS_MISC));
    for (int ph2 = 2 * a_.ph_lo; ph2 < 2 * a_.ph_hi; ++ph2) {
        const int ph = ph2 >> 1;
        if (ph >= 1 && ph <= 12 * NL) { const int kq = (ph - 1) % 12; if (kq == 0 || kq == 3 || kq == 6 || kq == 9) continue; }
        if (ph2 & 1) { const bool dup = (ph >= 1 && ph <= 12 * NL && ((DUP_K >> ((ph - 1) % 12)) & 1)) || (ph == 0 && (DUP_K & 0x1000)); if (!dup) continue; }
        int tid = threadIdx.x, bid = blockIdx.x;
        asm volatile("" : "+v"(tid));
        asm volatile("" : "+s"(bid));
        unsigned char* ws = a_.ws; asm volatile("" : "+s"(ws));
        const Args& a = a_;
        bf16_t* H = (bf16_t*)(ws + WS_H); bf16_t* U = (bf16_t*)(ws + WS_U);
        if (ph == 0) {
            if (EN_P0) p0_phase(a, ws, lds, tid, bid);
        } else if (ph == 1 + 12 * NL) {
            final_norm_phase(H, a.out, a.in[22], (const float*)(ws + WS_SSP), tid, bid);
        } else {
            const int l = (ph - 1) / 12, k0_ = (ph - 1) % 12; const int k = ((EN_K >> k0_) & 1) ? k0_ : 99;
            const bf16_t* wl = (const bf16_t*)(ws + WS_W) + (size_t)l * W_LAYER;
            if (k == 1 || k == 10) {
                if (ph == 2) { const int gt = bid * 512 + tid; if (gt < 2048) { const float* PART = (const float*)(ws + WS_BPART); float sacc = 0.f;
#pragma unroll
                    for (int c = 0; c < 64; ++c) sacc += PART[c * 2048 + gt];
                    ((float*)(ws + WS_BIAS1))[gt] = sacc; } }
                pg8::Gemm g{H, wl + (k == 1 ? OFF_SW1 : OFF_SW2), T, 2 * FF, D, D}; pg8::StaticOrder S; S.init(T, 2 * FF, G, bid);
                if ((tid & 63) == 0) ((LAS int*)(lds + 139264))[tid >> 6] = -1;
                pg8::EpiSwiglu E{U, (const float*)(ws + WS_SSP), (LAS float*)(lds + 135168), (LAS int*)(lds + 139264), ph * 256 + 1}; pg8::gemm_phase(lds, g, S, E, tid);
            } else if (k == 2 || k == 11 || k == 8) {
                const bool wo = (k == 8); const int Kd = wo ? D : FF;
                pg8::Gemm g{wo ? (const bf16_t*)(ws + WS_ATT) : U, wl + (k == 2 ? OFF_DN1 : (k == 11 ? OFF_DN2 : OFF_WOUT)), T, D, Kd, Kd}; pg8::StaticOrder S; S.init(T, D, G, bid);
                pg8::EpiResid E{H, (float*)(ws + WS_SSP), wo ? 1.0f : 0.5f, (LAS float*)(lds + 131072)}; pg8::gemm_phase(lds, g, S, E, tid);
            } else if (k == 4) {
                pg8::Gemm g{H, wl + OFF_WIN, T, 2048, D, D}; pg8::StaticOrder S; S.init(T, 2048, G, bid);
                if ((tid & 63) == 0) ((LAS int*)(lds + 139264))[tid >> 6] = -1;
                pg8::EpiWinT<0> E{ws, (LAS float*)(lds + 135168), (LAS int*)(lds + 139264), ph * 256 + 1}; pg8::gemm_phase(lds, g, S, E, tid);
            } else if (k == 5) {
                { pg8::Gemm g{(const bf16_t*)(ws + WS_KCMP), (const bf16_t*)(ws + WS_CW1) + (size_t)l * 512 * 2048, 8192, 512, 2048, 1024}; pg8::CmpOrder S{G, bid};
                  pg8::EpiCmp1 E{(bf16_t*)(ws + WS_HID), (const float*)(ws + WS_BIAS1) + l * 512}; pg8::gemm_phase(lds, g, S, E, tid); }
                if (bid < 32) {
                    asm volatile("s_waitcnt vmcnt(0)" ::: "memory");
                    __builtin_amdgcn_fence(__ATOMIC_RELEASE, "agent");
                    asm volatile("s_waitcnt vmcnt(0)" ::: "memory");
                    __syncthreads();
                    __builtin_amdgcn_fence(__ATOMIC_ACQUIRE, "agent");
                    asm volatile("s_waitcnt vmcnt(0)" ::: "memory");
                    __syncthreads();
                    pg8::Gemm g{(const bf16_t*)(ws + WS_HID), (const bf16_t*)(ws + WS_CW2) + (size_t)l * 512 * 256, 8192, 512, 256, 256}; pg8::CmpOrder S{G, bid};
                    pg8::EpiCmp2 E{(bf16_t*)(ws + WS_KC), (bf16_t*)(ws + WS_VC)}; pg8::gemm_phase(lds, g, S, E, tid);
                }
                __syncthreads();
                {
                    pg8::Gemm g{H, wl + OFF_WIN + (size_t)2048 * D, T, 512, D, D}; pg8::AuxOrder S{bid - 32};
                    if ((tid & 63) == 0) ((LAS int*)(lds + 139264))[tid >> 6] = -1;
                    pg8::EpiWinT<8> E{ws, (LAS float*)(lds + 135168), (LAS int*)(lds + 139264), ph * 256 + 1}; pg8::gemm_phase(lds, g, S, E, tid);
                }
                __syncthreads();
                if (EN_CONV) conv_phase(a, ws, l, lds, tid, bid);
            } else if (k == 7) { if (EN_ATTN) attn_phase(ws, lds, tid, bid, l); }
        }
        if (ph2 + 1 < 2 * a_.ph_hi) { if (a_.ph_hi < 0) grid.sync();   xcd_barrier((unsigned*)(ws + WS_CTL), (volatile LAS unsigned*)(lds + LDS_MISC)); for (int e = 0; e < DUP_SYNC; ++e) xcd_barrier((unsigned*)(ws + WS_CTL), (volatile LAS unsigned*)(lds + LDS_MISC)); }
    }
}

extern "C" void kernel_launch(void* const* d_in, const int* in_sizes, int n_in, void* d_out, int out_size, void* d_ws, size_t ws_size, hipStream_t stream) {
    static int grid = 0;
    if (grid == 0) {
        if (n_in != 23 || out_size != T * D || ws_size < WS_END) { fprintf(stderr, "kernel_launch: unexpected shapes (n_in %d out %d ws %zu)\n", n_in, out_size, ws_size); grid = -1; return; }
        int dev = 0, cus = 0, per_cu = 0;
        (void)hipGetDevice(&dev);
        (void)hipDeviceGetAttribute(&cus, hipDeviceAttributeMultiprocessorCount, dev);
        (void)hipFuncSetAttribute((const void*)fwd_megakernel, hipFuncAttributeMaxDynamicSharedMemorySize, LDS_BYTES);
        (void)hipOccupancyMaxActiveBlocksPerMultiprocessor(&per_cu, (const void*)fwd_megakernel, 512, LDS_BYTES);
        (void)hipGetLastError();
        grid = cus > 0 ? cus : 256;
    }
    if (grid < 0) return;
    if (hipMemsetAsync((char*)d_ws + WS_CTL, 0, CTL_BYTES, stream) != hipSuccess) { fprintf(stderr, "kernel_launch: memset of the barrier words failed\n"); return; }
    Args a{};
    for (int i = 0; i < 23; ++i) a.in[i] = (const float*)d_in[i];
    a.out = (float*)d_out; a.ws = (unsigned char*)d_ws; a.ph_lo = 0; a.ph_hi = 2 + 12 * NL;
    void* args[] = {&a};
    hipError_t e = hipLaunchCooperativeKernel((const void*)fwd_megakernel, dim3(grid), dim3(512), args, LDS_BYTES, stream);
    if (e != hipSuccess) fprintf(stderr, "cooperative launch failed: %s (grid %d)\n", hipGetErrorString(e), grid);
}
```
